# Optimizing an MI355X kernel written in HIP

```python
import jax, jax.numpy as jnp
from jax import lax
import numpy as np

D_MODEL = 1024
BATCH = 8
SEQ = 2048
DEPTH = 2

N_RET_HEADS = 4
RET_QK_DIM = 256
RET_V_DIM = 512
RET_CHUNK = 128
N_ATT_HEADS = 8
ATT_HEAD_DIM = 128
N_IDX_HEADS = 8
IDX_DIM = 64
TOPK_MAX = 256
Q_BLOCK = 128
N_GROUPS = 4
EXPERTS_PER_GROUP = 8
N_EXPERTS = N_GROUPS * EXPERTS_PER_GROUP
TOP_K_EXPERTS = 2
EXPERT_FF = 512
DISPATCH_BLOCK = 128
ROPE_THETA = 10000.0
LN_EPS = 1e-5
GN_EPS = 1e-5
DEEPNORM_ALPHA = (2 * DEPTH) ** 0.25
DEEPNORM_BETA = (8 * DEPTH) ** -0.25

RET_Q_W = N_RET_HEADS * RET_QK_DIM
RET_V_W = N_RET_HEADS * RET_V_DIM
ATT_Q_W = N_ATT_HEADS * ATT_HEAD_DIM
IDX_Q_W = N_IDX_HEADS * IDX_DIM
COL_SIZES = (RET_Q_W, RET_Q_W, RET_V_W, RET_V_W, ATT_Q_W, ATT_HEAD_DIM, ATT_HEAD_DIM,
             IDX_Q_W, IDX_DIM, N_IDX_HEADS, D_MODEL, D_MODEL)
IN_WIDTH = sum(COL_SIZES)

kernel_name = 'hybrid_retention_dsa_hiermoe_deepnorm'


def layer_norm(x, g, b):
    xf = x.astype(jnp.float32)
    mu = xf.mean(-1, keepdims=True)
    var = jnp.square(xf - mu).mean(-1, keepdims=True)
    y = (xf - mu) * lax.rsqrt(var + LN_EPS)
    return (y * g.astype(jnp.float32) + b.astype(jnp.float32)).astype(x.dtype)


def rotary(x, pos):
    d = x.shape[-1]
    inv = 1.0 / (ROPE_THETA ** (jnp.arange(0, d, 2, dtype=jnp.float32) / d))
    ang = pos.astype(jnp.float32)[:, None] * inv[None, :]
    cos = jnp.cos(ang)[None, :, None, :].astype(x.dtype)
    sin = jnp.sin(ang)[None, :, None, :].astype(x.dtype)
    x1, x2 = x[..., : d // 2], x[..., d // 2:]
    return jnp.concatenate([x1 * cos - x2 * sin, x2 * cos + x1 * sin], axis=-1)


def retention(q, k, v, g):
    B, S, H, dk = q.shape
    dv = v.shape[-1]
    C = RET_CHUNK
    N = S // C
    log_gamma = jnp.log(1.0 - 2.0 ** (-5.0 - jnp.arange(H, dtype=jnp.float32)))
    pos = jnp.arange(C, dtype=jnp.float32)
    diff = pos[:, None] - pos[None, :]
    decay_intra = jnp.where(diff >= 0,
                            jnp.exp(jnp.maximum(diff, 0.0)[None] * log_gamma[:, None, None]),
                            0.0)
    xi = jnp.exp((pos[:, None] + 1.0) * log_gamma[None, :])
    zeta = jnp.exp((C - 1.0 - pos)[:, None] * log_gamma[None, :])
    gamma_c = jnp.exp(C * log_gamma)
    k = k * (dk ** -0.5)
    qc = q.reshape(B, N, C, H, dk)
    kc = k.reshape(B, N, C, H, dk)
    vc = v.reshape(B, N, C, H, dv)
    scores = jnp.einsum('bnchd,bnmhd->bnhcm', qc, kc) * decay_intra.astype(q.dtype)
    intra = jnp.einsum('bnhcm,bnmhe->bnche', scores, vc)

    def step(R, xs):
        qn, kn, vn = xs
        cross = jnp.einsum('bchd,bhde->bche', qn * xi[None, :, :, None].astype(qn.dtype),
                           R.astype(qn.dtype))
        upd = jnp.einsum('bchd,bche->bhde', kn * zeta[None, :, :, None].astype(kn.dtype), vn)
        R = gamma_c[None, :, None, None] * R + upd.astype(jnp.float32)
        return R, cross

    R0 = jnp.zeros((B, H, dk, dv), jnp.float32)
    _, cross = lax.scan(step, R0, (jnp.moveaxis(qc, 1, 0), jnp.moveaxis(kc, 1, 0),
                                   jnp.moveaxis(vc, 1, 0)))
    y = (intra + jnp.moveaxis(cross, 0, 1)).reshape(B, S, H, dv).astype(jnp.float32)
    mu = y.mean(-1, keepdims=True)
    var = jnp.square(y - mu).mean(-1, keepdims=True)
    yn = ((y - mu) * lax.rsqrt(var + GN_EPS)).reshape(B, S, H * dv).astype(g.dtype)
    return yn * jax.nn.silu(g)


def dsa_attention(q, k, v, qi, ki, wi):
    B, S, H, hd = q.shape
    K = min(TOPK_MAX, S // 4)
    NB = S // Q_BLOCK
    key_pos = jnp.arange(S)
    idx_scale = (IDX_DIM ** -0.5) * (N_IDX_HEADS ** -0.5)
    gather = jax.vmap(lambda a, i: a[i])

    def block(xs):
        qb, qib, wib, t0 = xs
        t = t0 + jnp.arange(Q_BLOCK)
        rel = jax.nn.relu(jnp.einsum('bthd,bsd->bths', qib, ki).astype(jnp.float32))
        score = jnp.einsum('bths,bth->bts', rel, wib.astype(jnp.float32)) * idx_scale
        visible = key_pos[None, None, :] <= t[None, :, None]
        score = jnp.where(visible, score, -jnp.inf)
        _, sel = lax.top_k(score, K)
        k_sel = gather(k, sel)
        v_sel = gather(v, sel)
        s = jnp.einsum('bthd,btkd->bthk', qb, k_sel).astype(jnp.float32) * (hd ** -0.5)
        valid = (sel <= t[None, :, None])[:, :, None, :]
        p = jax.nn.softmax(jnp.where(valid, s, -jnp.inf), axis=-1)
        return jnp.einsum('bthk,btkd->bthd', p.astype(v.dtype), v_sel)

    def to_blocks(a):
        return jnp.moveaxis(a.reshape((B, NB, Q_BLOCK) + a.shape[2:]), 1, 0)

    out = lax.map(block, (to_blocks(q), to_blocks(qi), to_blocks(wi),
                          jnp.arange(NB) * Q_BLOCK))
    return jnp.moveaxis(out, 0, 1).reshape(B, S, H * hd)


def hybrid_mixer(x, w_in, w_ret_o, w_dsa_o, w_out):
    B, S, _ = x.shape
    pos = jnp.arange(S)
    proj = x @ w_in
    offsets = [int(o) for o in np.cumsum(COL_SIZES)[:-1]]
    rq, rk, rv, rg, aq, ak, av, iq, ik, iw, gr, ga = jnp.split(proj, offsets, axis=-1)
    rq = rotary(rq.reshape(B, S, N_RET_HEADS, RET_QK_DIM), pos)
    rk = rotary(rk.reshape(B, S, N_RET_HEADS, RET_QK_DIM), pos)
    rv = rv.reshape(B, S, N_RET_HEADS, RET_V_DIM)
    aq = rotary(aq.reshape(B, S, N_ATT_HEADS, ATT_HEAD_DIM), pos)
    ak = rotary(ak[:, :, None, :], pos)[:, :, 0]
    iq = rotary(iq.reshape(B, S, N_IDX_HEADS, IDX_DIM), pos)
    ik = rotary(ik[:, :, None, :], pos)[:, :, 0]
    ret = retention(rq, rk, rv, rg)
    att = dsa_attention(aq, ak, av, iq, ik, iw)
    merged = jax.nn.sigmoid(gr) * (ret @ w_ret_o) + jax.nn.sigmoid(ga) * (att @ w_dsa_o)
    return merged @ w_out


def hierarchical_moe(h, grp_w, grp_b, exp_w, exp_b, w_gate, w_up, w_down):
    B, S, D = h.shape
    T = B * S
    xt = h.reshape(T, D)
    grp_logits = (xt @ grp_w + grp_b).astype(jnp.float32)
    grp_prob = jax.nn.softmax(grp_logits, axis=-1)
    _, g_sel = lax.top_k(grp_logits, 1)
    p_grp = jnp.take_along_axis(grp_prob, g_sel, axis=1)
    exp_logits = (xt @ exp_w + exp_b).astype(jnp.float32).reshape(T, N_GROUPS, EXPERTS_PER_GROUP)
    in_grp = jnp.take_along_axis(exp_logits, g_sel[:, :, None], axis=1)[:, 0]
    top_logit, top_idx = lax.top_k(in_grp, TOP_K_EXPERTS)
    gate = p_grp * jax.nn.softmax(top_logit, axis=-1)
    expert = g_sel * EXPERTS_PER_GROUP + top_idx
    A = T * TOP_K_EXPERTS
    e_flat = expert.reshape(A)
    tok = jnp.repeat(jnp.arange(T), TOP_K_EXPERTS)
    w_flat = gate.reshape(A)
    order = jnp.argsort(e_flat)
    e_s, tok_s, w_s = e_flat[order], tok[order], w_flat[order]
    counts = jnp.zeros((N_EXPERTS,), jnp.int32).at[e_flat].add(1)
    starts = jnp.cumsum(counts) - counts
    padded = (counts + DISPATCH_BLOCK - 1) // DISPATCH_BLOCK * DISPATCH_BLOCK
    pad_ends = jnp.cumsum(padded)
    pad_starts = pad_ends - padded
    dest = pad_starts[e_s] + jnp.arange(A) - starts[e_s]
    n_blocks = -(-A // DISPATCH_BLOCK) + N_EXPERTS
    x_pad = jnp.zeros((n_blocks * DISPATCH_BLOCK, D), h.dtype).at[dest].set(xt[tok_s])
    block_expert = jnp.minimum(
        jnp.searchsorted(pad_ends, jnp.arange(n_blocks) * DISPATCH_BLOCK, side='right'),
        N_EXPERTS - 1)

    def expert_block(args):
        xb, e = args
        return (jax.nn.silu(xb @ w_gate[e]) * (xb @ w_up[e])) @ w_down[e]

    y_pad = lax.map(expert_block, (x_pad.reshape(n_blocks, DISPATCH_BLOCK, D), block_expert))
    y = y_pad.reshape(-1, D)[dest] * w_s[:, None].astype(h.dtype)
    return jax.ops.segment_sum(y, tok_s, num_segments=T).reshape(B, S, D)


def setup_inputs(seed: int = 0) -> dict:
    key = jax.random.key(seed)
    ks = jax.random.split(key, 17)

    def normal(k, shape, scale):
        return jax.random.normal(k, shape, jnp.float32) * scale

    ef = (DEPTH, N_EXPERTS, D_MODEL, EXPERT_FF)
    return {
        'x': normal(ks[0], (BATCH, SEQ, D_MODEL), 1.0),
        'w_in': normal(ks[1], (DEPTH, D_MODEL, IN_WIDTH), D_MODEL ** -0.5),
        'w_ret_o': normal(ks[2], (DEPTH, RET_V_W, D_MODEL), RET_V_W ** -0.5),
        'w_dsa_o': normal(ks[3], (DEPTH, ATT_Q_W, D_MODEL), ATT_Q_W ** -0.5),
        'w_out': normal(ks[4], (DEPTH, D_MODEL, D_MODEL), D_MODEL ** -0.5 * DEEPNORM_BETA),
        'ln1_g': 1.0 + normal(ks[5], (DEPTH, D_MODEL), 0.02),
        'ln1_b': normal(ks[6], (DEPTH, D_MODEL), 0.02),
        'router_grp_w': normal(ks[7], (DEPTH, D_MODEL, N_GROUPS), D_MODEL ** -0.5),
        'router_grp_b': normal(ks[8], (DEPTH, N_GROUPS), 0.01),
        'router_exp_w': normal(ks[9], (DEPTH, D_MODEL, N_EXPERTS), D_MODEL ** -0.5),
        'router_exp_b': normal(ks[10], (DEPTH, N_EXPERTS), 0.01),
        'w_gate': normal(ks[11], ef, D_MODEL ** -0.5),
        'w_up': normal(ks[12], ef, D_MODEL ** -0.5),
        'w_down': normal(ks[13], (DEPTH, N_EXPERTS, EXPERT_FF, D_MODEL),
                         EXPERT_FF ** -0.5 * DEEPNORM_BETA),
        'ln2_g': 1.0 + normal(ks[14], (DEPTH, D_MODEL), 0.02),
        'ln2_b': normal(ks[15], (DEPTH, D_MODEL), 0.02),
    }


def reference(x, w_in, w_ret_o, w_dsa_o, w_out, ln1_g, ln1_b, router_grp_w, router_grp_b,
              router_exp_w, router_exp_b, w_gate, w_up, w_down, ln2_g, ln2_b):
    for l in range(DEPTH):
        mix = hybrid_mixer(x, w_in[l], w_ret_o[l], w_dsa_o[l], w_out[l])
        h = layer_norm(DEEPNORM_ALPHA * x + mix, ln1_g[l], ln1_b[l])
        ffn = hierarchical_moe(h, router_grp_w[l], router_grp_b[l], router_exp_w[l],
                               router_exp_b[l], w_gate[l], w_up[l], w_down[l])
        x = layer_norm(DEEPNORM_ALPHA * h + ffn, ln2_g[l], ln2_b[l])
    return x
```

```cpp
#include <hip/hip_runtime.h>
#include <cstdio>
#include <cstdint>

#define GAS __attribute__((address_space(1)))
#define LAS __attribute__((address_space(3)))
typedef unsigned short bf16_t;
typedef short bf16x8 __attribute__((ext_vector_type(8)));
typedef short s16x4 __attribute__((ext_vector_type(4)));
typedef float f32x4 __attribute__((ext_vector_type(4)));
typedef float f32x2 __attribute__((ext_vector_type(2)));
typedef float f32x16 __attribute__((ext_vector_type(16)));
typedef unsigned u32x4 __attribute__((ext_vector_type(4)));
typedef unsigned u32x2 __attribute__((ext_vector_type(2)));
typedef __bf16 bf16x2_t __attribute__((ext_vector_type(2)));
typedef GAS unsigned gu32;

constexpr int D_MODEL = 1024, BATCH = 8, SEQ = 2048, DEPTH = 2, T = BATCH * SEQ;
constexpr int IN_WIDTH = 10056, NV = 10240;
constexpr int N_EXPERTS = 32, EXPERT_FF = 512;
constexpr float LN_EPS = 1e-5f, GN_EPS = 1e-5f;
constexpr float ALPHA = 1.4142135623730951f;
constexpr int NWAVES = 8, NTHREADS = 512;
#ifndef PH_MASK
#define PH_MASK 0xFFFF
#endif
#define PH(k) ((PH_MASK >> (k)) & 1)

constexpr size_t MiB = 1u << 20;
constexpr size_t WS_CTL = 0, CTL_BYTES = 1 * MiB;
constexpr size_t WS_WIN = 1 * MiB;
constexpr size_t WS_WR = WS_WIN + 20 * MiB;
constexpr size_t WS_WD = WS_WR + 4 * MiB;
constexpr size_t WS_WO = WS_WD + 2 * MiB;
constexpr size_t WS_WGU = WS_WO + 2 * MiB;
constexpr size_t WS_WDN = WS_WGU + 64 * MiB;
constexpr size_t WS_RQK = WS_WDN + 32 * MiB;
constexpr size_t WS_RV = WS_RQK + 64 * MiB;
constexpr size_t WS_RG = WS_RV + 64 * MiB;
constexpr size_t WS_AQ = WS_RG + 64 * MiB;
constexpr size_t WS_AKV = WS_AQ + 32 * MiB;
constexpr size_t WS_IQ = WS_AKV + 8 * MiB;
constexpr size_t WS_IK = WS_IQ + 16 * MiB;
constexpr size_t WS_IW = WS_IK + 2 * MiB;
constexpr size_t WS_GATES = WS_IW + 1 * MiB;
constexpr size_t WS_Y = WS_GATES + 64 * MiB;
constexpr size_t WS_XB = WS_Y + 64 * MiB;
constexpr size_t WS_MASK = WS_XB + 32 * MiB;
constexpr size_t WS_STATS = WS_MASK + 4 * MiB;
constexpr size_t WS_LIST = WS_STATS + 8 * MiB;
constexpr size_t WS_TOKSLOT = WS_LIST + 2 * MiB;
constexpr size_t WS_END = WS_TOKSLOT + 1 * MiB;
constexpr size_t WS_TMP32 = WS_RQK, WS_H = WS_RQK, WS_ACT = WS_RV, WS_Y2 = WS_RG;
static_assert(WS_END <= 558 * MiB, "workspace map exceeds the guaranteed size");
static_assert(WS_ACT + (size_t)40960 * 512 * 2 <= WS_RG && WS_Y2 + (size_t)40960 * 1024 * 2 <= WS_AKV, "MoE overlays");

constexpr int CW_BAR = 4096;
constexpr int CW_CNT = 16384;

constexpr int RING_BYTES = 131072;
constexpr int ROUTER_W_BYTES = 36 * 1024 * 4;
constexpr int MISC_OFF = ROUTER_W_BYTES;
constexpr int P6S_OFF = MISC_OFF + 1024;
constexpr int LDS_BYTES = MISC_OFF + 8192;

__device__ __forceinline__ float bf2f(unsigned b) { return __uint_as_float(b << 16); }
__device__ __forceinline__ unsigned cvtpk(float lo, float hi) { f32x2 v = {lo, hi}; bf16x2_t b = __builtin_convertvector(v, bf16x2_t); return __builtin_bit_cast(unsigned, b); }
__device__ __forceinline__ float wave_sum(float v) {
#pragma unroll
    for (int o = 1; o < 64; o <<= 1) v += __shfl_xor(v, o);
    return v;
}
__device__ __forceinline__ float half_sum(float v) {
#pragma unroll
    for (int o = 1; o < 32; o <<= 1) v += __shfl_xor(v, o);
    return v;
}
__device__ __forceinline__ float sigmoidf_(float x) { return 1.0f / (1.0f + __expf(-x)); }
#define LDS_WAIT() asm volatile("s_waitcnt lgkmcnt(0)" ::: "memory")
#define VM_WAIT() asm volatile("s_waitcnt vmcnt(0)" ::: "memory")
#define RLX_AGENT __ATOMIC_RELAXED, __HIP_MEMORY_SCOPE_AGENT

namespace pg8 {
constexpr int BM = 256, BK = 64, HALF = 128, HTB = HALF * BK * 2, STAGE_BYTES = 8 * HTB, NXCD = 8, WGM = 8;
__host__ __device__ __forceinline__ int lds_byte(int r, int c) { const int st = (r >> 4) * 2 + (c >> 5), rr = r & 15, cc = c & 31, ob = rr * 64 + cc * 2; return st * 1024 + (ob ^ (((ob >> 9) & 1) << 5)); }
__host__ __device__ __forceinline__ void stage_rc(int b, int& R, int& C) { const int st = b / 1024, sb = b % 1024, swz = sb ^ (((sb >> 9) & 1) << 5); R = (st >> 1) * 16 + swz / 64; C = (st & 1) * 32 + (swz % 64) / 2; }

struct Unit { int pm, pn; const char* a; const char* b; };

template <class Epi, class Sched, bool ALIGN_EPI, bool GATHER>
__device__ __forceinline__ void gemm_phase(LAS unsigned char* lds, const int tid, const int K, const Sched& S, const Epi& E) {
    const int wid = __builtin_amdgcn_readfirstlane(tid >> 6), lane = tid & 63, wr = wid >> 2, wc = wid & 3, fr = lane & 15, fq = lane >> 4;
    const int nt = K / BK;
    unsigned vb[2];
#pragma unroll
    for (int i = 0; i < 2; ++i) { int R, C; stage_rc(tid * 16 + i * 8192, R, C); vb[i] = (unsigned)(R * K + C) * 2u; }
    const size_t kstep = (size_t)(BK * 2);
    const size_t hstepB = (size_t)HALF * K * 2;
    const unsigned ldsw = (unsigned)wid * 1024u;
    const int aoff = lds_byte(wr * 64 + fr, fq * 8), boff = lds_byte(wc * 32 + fr, fq * 8);
#define PG8_SA(b, h) (((b) * 2 + (h)) * HTB)
#define PG8_SB(b, h) ((4 + (b) * 2 + (h)) * HTB)
#define PG8_STAGE(bufoff, gbase, voff) do { _Pragma("unroll") for (int _i = 0; _i < 2; ++_i) \
        __builtin_amdgcn_global_load_lds((const unsigned*)((const char*)(gbase) + (voff)[_i]), (LAS unsigned*)(lds + (bufoff) + ldsw + _i * 8192), 16, 0, 0); } while (0)
#define PG8_LDA(dst, b, h) do { _Pragma("unroll") for (int m = 0; m < 4; ++m) _Pragma("unroll") for (int k = 0; k < 2; ++k) dst[m][k] = *(const LAS bf16x8*)(lds + PG8_SA(b, h) + aoff + m * 2048 + k * 1024); } while (0)
#define PG8_LDB(dst, b, h) do { _Pragma("unroll") for (int n = 0; n < 2; ++n) _Pragma("unroll") for (int k = 0; k < 2; ++k) dst[n][k] = *(const LAS bf16x8*)(lds + PG8_SB(b, h) + boff + n * 2048 + k * 1024); } while (0)
#define PG8_MMA(ai, bj, At, Bt) do { __builtin_amdgcn_s_setprio(1); _Pragma("unroll") for (int m = 0; m < 4; ++m) _Pragma("unroll") for (int n = 0; n < 2; ++n) _Pragma("unroll") for (int k = 0; k < 2; ++k) \
        acc[ai][bj][m][n] = __builtin_amdgcn_mfma_f32_16x16x32_bf16(Bt[n][k], At[m][k], acc[ai][bj][m][n], 0, 0, 0); __builtin_amdgcn_s_setprio(0); } while (0)
#define PG8_WAIT_V(n) asm volatile("s_waitcnt vmcnt(" #n ")" ::: "memory")
#define PG8_WAIT_L(n) asm volatile("s_waitcnt lgkmcnt(" #n ")" ::: "memory")
#define PG8_BAR __builtin_amdgcn_s_barrier()
#define PG8_SCHED __builtin_amdgcn_sched_barrier(0)
    Unit cur, nxt; int ui = 0;
    if (!S.next(0, cur)) return;
    f32x4 acc[2][2][4][2];
#pragma unroll
    for (int a = 0; a < 2; ++a)
#pragma unroll
        for (int b = 0; b < 2; ++b)
#pragma unroll
            for (int m = 0; m < 4; ++m)
#pragma unroll
                for (int n = 0; n < 2; ++n) acc[a][b][m][n] = (f32x4){0.f, 0.f, 0.f, 0.f};
    bf16x8 At[4][2], B0[2][2], B1[2][2];
    const char* cA = cur.a; const char* cB = cur.b;
    unsigned cva[2][2], nva[2][2];
    S.va_of(cur, cva);
    const size_t hstepA = GATHER ? (size_t)0 : (size_t)S.half_step_a();
#define CVA1 (GATHER ? cva[1] : cva[0])
#define XVA1 (GATHER ? xva[1] : xva[0])
    PG8_STAGE(PG8_SB(0, 0), cB, vb); PG8_STAGE(PG8_SB(0, 1), cB + hstepB, vb); PG8_STAGE(PG8_SA(0, 0), cA, cva[0]); PG8_STAGE(PG8_SA(0, 1), cA + hstepA, CVA1);
    if (wr == 1) PG8_BAR;
    PG8_WAIT_V(2); PG8_BAR;
    PG8_STAGE(PG8_SB(1, 0), cB + kstep, vb); PG8_STAGE(PG8_SA(1, 0), cA + kstep, cva[0]); PG8_STAGE(PG8_SB(1, 1), cB + hstepB + kstep, vb);
    PG8_WAIT_V(6); PG8_BAR;
    for (;;) {
        const bool has_next = S.next(ui + 1, nxt);
        const char* nA = has_next ? nxt.a : cA; const char* nB = has_next ? nxt.b : cB;
        if constexpr (GATHER) { if (has_next) S.va_of(nxt, nva); else {
#pragma unroll
            for (int h = 0; h < 2; ++h)
#pragma unroll
                for (int i = 0; i < 2; ++i) nva[h][i] = cva[h][i]; } }
        for (int t = 0; t < nt; t += 2) {
            const bool last = (t == nt - 2);
            const char* a1 = cA + (size_t)(t + 1) * kstep;
            const char* a2 = last ? nA : cA + (size_t)(t + 2) * kstep; const char* b2 = last ? nB : cB + (size_t)(t + 2) * kstep;
            const char* a3 = a2 + kstep; const char* b3 = b2 + kstep;
            unsigned xva[2][2];
#pragma unroll
            for (int h = 0; h < 2; ++h)
#pragma unroll
                for (int i = 0; i < 2; ++i) xva[h][i] = (GATHER && last) ? nva[h][i] : cva[h][i];
            PG8_LDB(B0, 0, 0); PG8_LDB(B1, 0, 1); PG8_SCHED; PG8_LDA(At, 0, 0); PG8_STAGE(PG8_SA(1, 1), a1 + hstepA, CVA1);
            PG8_WAIT_V(8); PG8_WAIT_L(0); PG8_BAR; PG8_MMA(0, 0, At, B0); PG8_MMA(0, 1, At, B1); PG8_BAR; PG8_SCHED;
            PG8_LDA(At, 0, 1); PG8_STAGE(PG8_SB(0, 0), b2, vb); PG8_STAGE(PG8_SB(0, 1), b2 + hstepB, vb); PG8_STAGE(PG8_SA(0, 0), a2, xva[0]);
            PG8_WAIT_V(8); PG8_WAIT_L(0); PG8_BAR; PG8_MMA(1, 0, At, B0); PG8_MMA(1, 1, At, B1); PG8_BAR; PG8_SCHED;
            PG8_LDB(B0, 1, 0); PG8_LDB(B1, 1, 1); PG8_SCHED; PG8_LDA(At, 1, 0); PG8_STAGE(PG8_SA(0, 1), a2 + hstepA, XVA1);
            PG8_WAIT_V(8); PG8_WAIT_L(0); PG8_BAR; PG8_MMA(0, 0, At, B0); PG8_MMA(0, 1, At, B1); PG8_BAR; PG8_SCHED;
            PG8_LDA(At, 1, 1); PG8_STAGE(PG8_SB(1, 0), b3, vb); PG8_STAGE(PG8_SB(1, 1), b3 + hstepB, vb); PG8_STAGE(PG8_SA(1, 0), a3, xva[0]);
            PG8_WAIT_V(8); PG8_WAIT_L(0); PG8_BAR; PG8_MMA(1, 0, At, B0); PG8_MMA(1, 1, At, B1); PG8_BAR; PG8_SCHED;
        }
        if constexpr (ALIGN_EPI) { if (wr == 0) PG8_BAR; }
        E(acc, cur, wr, wc, fr, fq);
        if (!has_next) break;
#pragma unroll
        for (int a = 0; a < 2; ++a)
#pragma unroll
            for (int b = 0; b < 2; ++b)
#pragma unroll
                for (int m = 0; m < 4; ++m)
#pragma unroll
                    for (int n = 0; n < 2; ++n) acc[a][b][m][n] = (f32x4){0.f, 0.f, 0.f, 0.f};
        cur = nxt; cA = nA; cB = nB; ++ui;
        if constexpr (GATHER) {
#pragma unroll
            for (int h = 0; h < 2; ++h)
#pragma unroll
                for (int i = 0; i < 2; ++i) cva[h][i] = nva[h][i]; }
        if constexpr (ALIGN_EPI) { if (wr == 1) PG8_BAR; }
    }
    PG8_WAIT_V(0);
    if constexpr (!ALIGN_EPI) { if (wr == 0) PG8_BAR; }
    PG8_BAR;
#undef CVA1
#undef XVA1
#undef PG8_SA
#undef PG8_SB
#undef PG8_STAGE
#undef PG8_LDA
#undef PG8_LDB
#undef PG8_MMA
#undef PG8_WAIT_V
#undef PG8_WAIT_L
#undef PG8_BAR
#undef PG8_SCHED
}

__device__ __forceinline__ void plain_va(unsigned (&va)[2][2], int lda, int tid) {
#pragma unroll
    for (int i = 0; i < 2; ++i) { int R, C; stage_rc(tid * 16 + i * 8192, R, C); va[0][i] = (unsigned)(R * lda + C) * 2u; va[1][i] = (unsigned)((R + HALF) * lda + C) * 2u; }
}
struct DenseSched {
    const bf16_t* A; const bf16_t* Bt; int lda, K, nM, nN, nwg, G, c;
    unsigned va[2][2];
    __device__ __forceinline__ void init(const bf16_t* A_, int lda_, const bf16_t* Bt_, int M, int N, int K_, int G_, int c_, int tid_) {
        A = A_; lda = lda_; Bt = Bt_; K = K_; nM = M / BM; nN = N / BM; nwg = nM * nN; G = G_; c = c_; plain_va(va, lda_, tid_); }
    __device__ __forceinline__ bool next(int i, Unit& u) const {
        const long L = (long)i * G + c; if (L >= nwg) return false;
        int wgid = (int)L; { const int q = nwg / NXCD, r = nwg % NXCD, xcd = wgid % NXCD, off = wgid / NXCD; wgid = (xcd < r ? xcd * (q + 1) : r * (q + 1) + (xcd - r) * q) + off; }
        const int nig = WGM * nN, gid = wgid / nig, fm = gid * WGM, gsz = (nM - fm) < WGM ? (nM - fm) : WGM;
        u.pm = fm + ((wgid % nig) % gsz); u.pn = (wgid % nig) / gsz;
        u.a = (const char*)A + (size_t)u.pm * BM * lda * 2; u.b = (const char*)Bt + (size_t)u.pn * BM * K * 2;
        return true;
    }
    __device__ __forceinline__ size_t half_step_a() const { return (size_t)HALF * lda * 2; }
    __device__ __forceinline__ void va_of(const Unit&, unsigned (&v)[2][2]) const {
#pragma unroll
        for (int h = 0; h < 2; ++h)
#pragma unroll
            for (int i2 = 0; i2 < 2; ++i2) v[h][i2] = va[h][i2];
    }
};
}

#define XB_TMO      128
#define XB_XCNT(j)  (256  + 64 * (j))
#define XB_XSUB(j)  (1280 + 64 * (j))
#define XB_XGEN(j)  (2304 + 64 * (j))
#define XB_TOP      3328
#define XB_TOPGEN   3392
#define XCD_BAR_WORDS 3456
#define XB_SPIN_CAP (1u << 22)
__device__ __forceinline__ unsigned xb_ld(unsigned* p)              { return __hip_atomic_load(p, __ATOMIC_RELAXED, __HIP_MEMORY_SCOPE_AGENT); }
__device__ __forceinline__ unsigned xb_add(unsigned* p, unsigned v) { return __hip_atomic_fetch_add(p, v, __ATOMIC_RELAXED, __HIP_MEMORY_SCOPE_AGENT); }
__device__ __forceinline__ unsigned xb_xcc_id() { return (unsigned)__builtin_amdgcn_s_getreg((3 << 11) | 20) & 0xFu; }
#define XB_SPIN(cond, bar) do { unsigned _sp = 0; while (cond) { __builtin_amdgcn_s_sleep(1); \
    if ((++_sp & 255u) == 0u) { if (xb_ld(&(bar)[XB_TMO])) break; if (_sp > XB_SPIN_CAP) { atomicAdd(&(bar)[XB_TMO], 1u); break; } } } } while (0)
struct XcdBarrier { unsigned* bar; unsigned x; volatile LAS unsigned* st; };
__device__ __forceinline__ XcdBarrier xcd_barrier_post(unsigned* bar, volatile LAS unsigned* st) {
    XcdBarrier b; b.bar = bar; b.x = xb_xcc_id(); b.st = st;
    if (threadIdx.x == 0) (void)xb_add(&bar[XB_XCNT(b.x)], 1u);
    return b;
}
__device__ __forceinline__ void xcd_barrier_complete(unsigned* bar, unsigned x, unsigned& nloc, unsigned& nx) {
    const unsigned G = gridDim.x * gridDim.y * gridDim.z;
    unsigned sum, cnt, mine, sp = 0u;
    for (;;) {
        sum = 0u; cnt = 0u; mine = 0u;
#pragma unroll
        for (unsigned j = 0; j < 16; ++j) { const unsigned c = xb_ld(&bar[XB_XCNT(j)]); sum += c; cnt += (c > 0u) ? 1u : 0u; mine = (j == x) ? c : mine; }
        if (sum == G) break;
        __builtin_amdgcn_s_sleep(1);
        if ((++sp & 255u) == 0u) { if (xb_ld(&bar[XB_TMO])) break; if (sp > XB_SPIN_CAP) { atomicAdd(&bar[XB_TMO], 1u); break; } }
    }
    nloc = mine > 0u ? mine : 1u; nx = cnt > 0u ? cnt : 1u;
}
__device__ __forceinline__ void xcd_barrier(const XcdBarrier& b) {
    asm volatile("s_waitcnt vmcnt(0)" ::: "memory");
    __syncthreads();
    if (threadIdx.x == 0) {
        unsigned* bar = b.bar;
        __builtin_amdgcn_s_waitcnt(0);
        unsigned nloc = b.st[0], nx = b.st[1];
        if (nloc == 0u) { xcd_barrier_complete(bar, b.x, nloc, nx); b.st[0] = nloc; b.st[1] = nx; }
        const unsigned old = xb_add(&bar[XB_XSUB(b.x)], 1u);
        const unsigned gen = old / nloc;
        if (old + 1u == (gen + 1u) * nloc) {
            __builtin_amdgcn_fence(__ATOMIC_RELEASE, "agent");
            asm volatile("s_waitcnt vmcnt(0)" ::: "memory");
            const unsigned og = xb_add(&bar[XB_TOP], 1u);
            const unsigned tg = og / nx;
            if (og + 1u == (tg + 1u) * nx) xb_add(&bar[XB_TOPGEN], 1u);
            else XB_SPIN(xb_ld(&bar[XB_TOPGEN]) == tg, bar);
            __builtin_amdgcn_fence(__ATOMIC_ACQUIRE, "agent");
            xb_add(&bar[XB_XGEN(b.x)], 1u);
            asm volatile("s_waitcnt vmcnt(0)" ::: "memory");
        } else {
            XB_SPIN(xb_ld(&bar[XB_XGEN(b.x)]) == gen, bar);
            __builtin_amdgcn_fence(__ATOMIC_ACQUIRE, "agent");
            asm volatile("s_waitcnt vmcnt(0)" ::: "memory");
        }
    }
    __syncthreads();
}

struct Args {
    const float* x; const float* w_in; const float* w_ret_o; const float* w_dsa_o; const float* w_out; const float* ln1_g; const float* ln1_b;
    const float* grp_w; const float* grp_b; const float* exp_w; const float* exp_b; const float* w_gate; const float* w_up; const float* w_down;
    const float* ln2_g; const float* ln2_b; float* out; unsigned char* ws;
};
struct Frame {
    LAS unsigned char* lds; int tid, lane, wave, vcu, G;
    unsigned char* ws;
};

__device__ __forceinline__ int rotmap(int a, int d) { const int hf = d >> 1; const int f = a >= hf ? 1 : 0; const int p = a - f * hf; return 32 * (p >> 4) + 16 * f + (p & 15); }
struct MapId { __device__ __forceinline__ int operator()(int n) const { return n; } };
struct MapGU { int f; __device__ __forceinline__ int operator()(int n) const { return 32 * (n >> 4) + 16 * f + (n & 15); } };
struct MapIn {
    __device__ __forceinline__ int operator()(int s) const {
        if (s < 2048) { return (s & ~255) + rotmap(s & 255, 256); }
        if (s < 6144) return s;
        if (s < 7168) { const int a = s - 6144; return 6144 + (a & ~127) + rotmap(a & 127, 128); }
        if (s < 7296) return 7168 + rotmap(s - 7168, 128);
        if (s < 7424) return s;
        if (s < 7936) { const int a = s - 7424; return 7424 + (a & ~63) + rotmap(a & 63, 64); }
        if (s < 8000) return 7936 + rotmap(s - 7936, 64);
        if (s < 8008) return s;
        if (s < 9032) return 8192 + (s - 8008);
        return 9216 + (s - 9032);
    }
};
template <class Map>
__device__ __forceinline__ void transpose_item(const float* __restrict__ W, int K, int N, bf16_t* WT, const Map map, LAS float* scr, int item, int lane) {
    const int nblk = (N + 31) >> 5, kb = item / nblk, nb = item - kb * nblk, k0 = 64 * kb, n0 = 32 * nb;
    const int nn = n0 + (lane & 31); const bool nok = nn < N;
#pragma unroll 8
    for (int i = 0; i < 32; ++i) { const int kk = 2 * i + (lane >> 5); scr[kk * 33 + (lane & 31)] = nok ? W[(size_t)(k0 + kk) * N + nn] : 0.f; }
    LDS_WAIT(); asm volatile("" ::: "memory");
    const int c = lane & 7;
#pragma unroll
    for (int j = 0; j < 4; ++j) { const int nl = (lane >> 3) + 8 * j; const int n = n0 + nl; const LAS float* s = scr + (8 * c) * 33 + nl;
        u32x4 o; o.x = cvtpk(s[0 * 33], s[1 * 33]); o.y = cvtpk(s[2 * 33], s[3 * 33]); o.z = cvtpk(s[4 * 33], s[5 * 33]); o.w = cvtpk(s[6 * 33], s[7 * 33]);
        if (n < N) *(u32x4*)(WT + (size_t)map(n) * K + k0 + 8 * c) = o; }
    LDS_WAIT(); asm volatile("" ::: "memory");
}
__device__ __forceinline__ void p0_convert(const Frame& F, const Args& A, int layer) {
    LAS float* scr = (LAS float*)(F.lds + F.wave * 16384);
    const int gw = F.vcu * NWAVES + F.wave, NGW = F.G * NWAVES;
    unsigned char* ws = F.ws;
    const float* w_in = A.w_in + (size_t)layer * 1024 * IN_WIDTH;
    const float* w_ro = A.w_ret_o + (size_t)layer * 2048 * 1024;
    const float* w_do = A.w_dsa_o + (size_t)layer * 1024 * 1024;
    const float* w_o = A.w_out + (size_t)layer * 1024 * 1024;
    const float* w_g = A.w_gate + (size_t)layer * 32 * 1024 * 512;
    const float* w_u = A.w_up + (size_t)layer * 32 * 1024 * 512;
    const float* w_d = A.w_down + (size_t)layer * 32 * 512 * 1024;
    constexpr int I_IN = 16 * 315, I_RO = 32 * 32, I_DO = 16 * 32, I_O = 16 * 32, I_G = 32 * 16 * 16, I_D = 32 * 8 * 32;
    constexpr int NITEMS = I_IN + I_RO + I_DO + I_O + 2 * I_G + I_D;
    for (int it = gw; it < NITEMS; it += NGW) {
        int r = it;
        if (r < I_IN) { transpose_item(w_in, 1024, IN_WIDTH, (bf16_t*)(ws + WS_WIN), MapIn{}, scr, r, F.lane); continue; } r -= I_IN;
        if (r < I_RO) { transpose_item(w_ro, 2048, 1024, (bf16_t*)(ws + WS_WR), MapId{}, scr, r, F.lane); continue; } r -= I_RO;
        if (r < I_DO) { transpose_item(w_do, 1024, 1024, (bf16_t*)(ws + WS_WD), MapId{}, scr, r, F.lane); continue; } r -= I_DO;
        if (r < I_O)  { transpose_item(w_o, 1024, 1024, (bf16_t*)(ws + WS_WO), MapId{}, scr, r, F.lane); continue; } r -= I_O;
        if (r < I_G)  { const int e = r >> 8; transpose_item(w_g + (size_t)e * 1024 * 512, 1024, 512, (bf16_t*)(ws + WS_WGU) + (size_t)e * 1024 * 1024, MapGU{0}, scr, r & 255, F.lane); continue; } r -= I_G;
        if (r < I_G)  { const int e = r >> 8; transpose_item(w_u + (size_t)e * 1024 * 512, 1024, 512, (bf16_t*)(ws + WS_WGU) + (size_t)e * 1024 * 1024, MapGU{1}, scr, r & 255, F.lane); continue; } r -= I_G;
        { const int e = r >> 8; transpose_item(w_d + (size_t)e * 512 * 1024, 512, 1024, (bf16_t*)(ws + WS_WDN) + (size_t)e * 1024 * 512, MapId{}, scr, r & 255, F.lane); }
    }
    { u32x4* z = (u32x4*)((bf16_t*)(ws + WS_WIN) + (size_t)8008 * 1024); const int n16 = 184 * 1024 * 2 / 16;
      for (int i = gw * 64 + F.lane; i < n16; i += NGW * 64) z[i] = (u32x4){0u, 0u, 0u, 0u}; }
    if (layer == 0) {
        const f32x4* xs = (const f32x4*)A.x; u32x2* xd = (u32x2*)(ws + WS_XB); const int n4 = T * D_MODEL / 4;
        for (int i = gw * 64 + F.lane; i < n4; i += NGW * 64) { const f32x4 v = xs[i]; u32x2 o; o.x = cvtpk(v.x, v.y); o.y = cvtpk(v.z, v.w); xd[i] = o; }
    }
}

struct EpiInProj {
    unsigned char* ws;
    __device__ __forceinline__ void operator()(const f32x4 (&acc)[2][2][4][2], const pg8::Unit& u, int wr, int wc, int fr, int fq) const {
        const int pn = u.pn;
        int kind;
        int dlog = 8; float scale = 1.f; bf16_t* dst = nullptr; int ldd = 0; int colbase = 0;
        if (pn < 4)        { kind = 0; dlog = 8; dst = (bf16_t*)(ws + WS_RQK); ldd = 2048; colbase = pn * 256; }
        else if (pn < 8)   { kind = 0; dlog = 8; scale = 0.0625f; dst = (bf16_t*)(ws + WS_RQK); ldd = 2048; colbase = 1024 + (pn - 4) * 256; }
        else if (pn < 16)  { kind = 1; dst = (bf16_t*)(ws + WS_RV); ldd = 2048; colbase = (pn - 8) * 256; }
        else if (pn < 24)  { kind = 2; dst = (bf16_t*)(ws + WS_RG); ldd = 2048; colbase = (pn - 16) * 256; }
        else if (pn < 28)  { kind = 0; dlog = 7; dst = (bf16_t*)(ws + WS_AQ); ldd = 1024; colbase = (pn - 24) * 256; }
        else if (pn == 28) { kind = 4; dlog = 7; dst = (bf16_t*)(ws + WS_AKV); ldd = 256; colbase = 0; }
        else if (pn < 31)  { kind = 0; dlog = 6; dst = (bf16_t*)(ws + WS_IQ); ldd = 512; colbase = (pn - 29) * 256; }
        else if (pn == 31) { kind = 5; dlog = 6; dst = (bf16_t*)(ws + WS_IK); ldd = 64; colbase = 0; }
        else               { kind = 3; dst = (bf16_t*)(ws + WS_GATES); ldd = 2048; colbase = (pn - 32) * 256; }
        const int row0 = u.pm * 256 + wr * 64 + fr;
#pragma unroll
        for (int bj = 0; bj < 2; ++bj) {
            const int G = 4 * bj + wc;
            bool rot = (kind == 0) || (kind == 4 && G < 4) || (kind == 5 && G < 2);
            if (rot) {
                const int d = 1 << dlog, gph = d >> 5, head = G / gph, g = G - head * gph;
                const int p0 = 16 * g + 4 * fq;
                float fr4[4];
#pragma unroll
                for (int j = 0; j < 4; ++j) fr4[j] = __builtin_amdgcn_exp2f(-(float)(p0 + j) * (2.0f / (float)d) * 13.287712379549449f) * 0.15915494309189535f;
                const int c1 = colbase + head * d + p0, c2 = c1 + (d >> 1);
#pragma unroll
                for (int ai = 0; ai < 2; ++ai)
#pragma unroll
                    for (int m = 0; m < 4; ++m) {
                        const int row = row0 + ai * 128 + m * 16; const float pos = (float)(row & (SEQ - 1));
                        const f32x4 x1 = acc[ai][bj][m][0], x2 = acc[ai][bj][m][1];
                        float o1[4], o2[4];
#pragma unroll
                        for (int j = 0; j < 4; ++j) { float rev = pos * fr4[j]; rev = rev - floorf(rev); const float sn = __builtin_amdgcn_sinf(rev), cs = __builtin_amdgcn_cosf(rev);
                            o1[j] = (x1[j] * cs - x2[j] * sn) * scale; o2[j] = (x2[j] * cs + x1[j] * sn) * scale; }
                        u32x2 w1, w2; w1.x = cvtpk(o1[0], o1[1]); w1.y = cvtpk(o1[2], o1[3]); w2.x = cvtpk(o2[0], o2[1]); w2.y = cvtpk(o2[2], o2[3]);
                        bf16_t* rp = dst + (size_t)row * ldd;
                        *(u32x2*)(rp + c1) = w1; *(u32x2*)(rp + c2) = w2;
                    }
            } else if (kind == 5) {
                if (G == 2 && fq < 2) {
                    float* iw = (float*)(ws + WS_IW);
#pragma unroll
                    for (int ai = 0; ai < 2; ++ai)
#pragma unroll
                        for (int m = 0; m < 4; ++m) { const int row = row0 + ai * 128 + m * 16; *(f32x4*)(iw + (size_t)row * 8 + 4 * fq) = acc[ai][bj][m][0]; }
                }
            } else {
                const int cb = (kind == 4) ? (128 + (G - 4) * 32) : (colbase + G * 32);
#pragma unroll
                for (int ai = 0; ai < 2; ++ai)
#pragma unroll
                    for (int m = 0; m < 4; ++m) {
                        const int row = row0 + ai * 128 + m * 16; bf16_t* rp = dst + (size_t)row * ldd + cb + 4 * fq;
#pragma unroll
                        for (int n = 0; n < 2; ++n) { f32x4 v = acc[ai][bj][m][n];
                            if (kind == 2) {
#pragma unroll
                                for (int j = 0; j < 4; ++j) v[j] = v[j] * sigmoidf_(v[j]);
                            } else if (kind == 3) {
#pragma unroll
                                for (int j = 0; j < 4; ++j) v[j] = sigmoidf_(v[j]);
                            }
                            u32x2 w; w.x = cvtpk(v[0], v[1]); w.y = cvtpk(v[2], v[3]); *(u32x2*)(rp + 16 * n) = w; }
                    }
            }
        }
    }
};
template <int MODE> struct EpiGate {
    const bf16_t* gates; int gcol0; float* tmp; bf16_t* merged;
    __device__ __forceinline__ void operator()(const f32x4 (&acc)[2][2][4][2], const pg8::Unit& u, int wr, int wc, int fr, int fq) const {
        const int row0 = u.pm * 256 + wr * 64 + fr, col0 = u.pn * 256 + wc * 32 + 4 * fq;
#pragma unroll
        for (int ai = 0; ai < 2; ++ai)
#pragma unroll
            for (int m = 0; m < 4; ++m) { const int row = row0 + ai * 128 + m * 16;
#pragma unroll
                for (int bj = 0; bj < 2; ++bj)
#pragma unroll
                    for (int n = 0; n < 2; ++n) { const int col = col0 + bj * 128 + n * 16;
                        const u32x2 gw = *(const u32x2*)(gates + (size_t)row * 2048 + gcol0 + col);
                        f32x4 g = {bf2f(gw.x & 0xffffu), bf2f(gw.x >> 16), bf2f(gw.y & 0xffffu), bf2f(gw.y >> 16)};
                        f32x4 v = acc[ai][bj][m][n] * g;
                        if (MODE == 0) { *(f32x4*)(tmp + (size_t)row * 1024 + col) = v; }
                        else { v = v + *(const f32x4*)(tmp + (size_t)row * 1024 + col); u32x2 w; w.x = cvtpk(v[0], v[1]); w.y = cvtpk(v[2], v[3]); *(u32x2*)(merged + (size_t)row * 1024 + col) = w; } }
                asm volatile("" ::: "memory"); }
    }
};
struct EpiResid {
    const float* x; float* out;
    __device__ __forceinline__ void operator()(const f32x4 (&acc)[2][2][4][2], const pg8::Unit& u, int wr, int wc, int fr, int fq) const {
        const int row0 = u.pm * 256 + wr * 64 + fr, col0 = u.pn * 256 + wc * 32 + 4 * fq;
#pragma unroll
        for (int ai = 0; ai < 2; ++ai)
#pragma unroll
            for (int m = 0; m < 4; ++m) { const int row = row0 + ai * 128 + m * 16;
#pragma unroll
                for (int bj = 0; bj < 2; ++bj)
#pragma unroll
                    for (int n = 0; n < 2; ++n) { const size_t off = (size_t)row * 1024 + col0 + bj * 128 + n * 16;
                        const f32x4 xv = *(const f32x4*)(x + off); *(f32x4*)(out + off) = xv * ALPHA + acc[ai][bj][m][n]; }
                asm volatile("" ::: "memory"); }
    }
};
struct EpiSwiGLU {
    bf16_t* act;
    __device__ __forceinline__ void operator()(const f32x4 (&acc)[2][2][4][2], const pg8::Unit& u, int wr, int wc, int fr, int fq) const {
        const int row0 = u.pm * 256 + wr * 64 + fr;
#pragma unroll
        for (int ai = 0; ai < 2; ++ai)
#pragma unroll
            for (int m = 0; m < 4; ++m) { const int row = row0 + ai * 128 + m * 16;
#pragma unroll
                for (int bj = 0; bj < 2; ++bj) { const int G = 4 * bj + wc; const f32x4 g = acc[ai][bj][m][0], up = acc[ai][bj][m][1]; float o[4];
#pragma unroll
                    for (int j = 0; j < 4; ++j) o[j] = g[j] * sigmoidf_(g[j]) * up[j];
                    u32x2 w; w.x = cvtpk(o[0], o[1]); w.y = cvtpk(o[2], o[3]);
                    *(u32x2*)(act + (size_t)row * 512 + u.pn * 128 + 16 * G + 4 * fq) = w; }
            }
    }
};
struct EpiPlain {
    bf16_t* y; int ldy;
    __device__ __forceinline__ void operator()(const f32x4 (&acc)[2][2][4][2], const pg8::Unit& u, int wr, int wc, int fr, int fq) const {
        const int row0 = u.pm * 256 + wr * 64 + fr, col0 = u.pn * 256 + wc * 32 + 4 * fq;
#pragma unroll
        for (int ai = 0; ai < 2; ++ai)
#pragma unroll
            for (int m = 0; m < 4; ++m) { const int row = row0 + ai * 128 + m * 16;
#pragma unroll
                for (int bj = 0; bj < 2; ++bj)
#pragma unroll
                    for (int n = 0; n < 2; ++n) { const f32x4 v = acc[ai][bj][m][n]; u32x2 w; w.x = cvtpk(v[0], v[1]); w.y = cvtpk(v[2], v[3]);
                        *(u32x2*)(y + (size_t)row * ldy + col0 + bj * 128 + n * 16) = w; }
            }
    }
};

struct MoeSched {
    const LAS int* tstart; const LAS int* cnt; const bf16_t* A; int lda; const bf16_t* Bt; size_t bstride; int K; int G, c; bool gather; const unsigned* list;
    unsigned va[2][2]; int tid;
    __device__ __forceinline__ int expert_of(int mt) const { int e = 0; for (int j = 1; j < 32; ++j) e += (tstart[j] <= mt) ? 1 : 0; return __builtin_amdgcn_readfirstlane(e); }
    __device__ __forceinline__ bool next(int i, pg8::Unit& u) const {
        const int L = i * G + c; const int total = __builtin_amdgcn_readfirstlane(tstart[32]) * 4; if (L >= total) return false;
        const int mt = L >> 2, pn = L & 3; const int e = expert_of(mt);
        u.pm = mt; u.pn = pn;
        u.b = (const char*)Bt + (size_t)e * bstride * 2 + (size_t)pn * 256 * K * 2;
        u.a = gather ? (const char*)A : (const char*)A + (size_t)mt * 256 * lda * 2;
        return true;
    }
    __device__ __forceinline__ size_t half_step_a() const { return (size_t)128 * lda * 2; }
    __device__ __forceinline__ void va_of(const pg8::Unit& u, unsigned (&v)[2][2]) const {
        if (gather) {
            const int e = expert_of(u.pm); const int rowbase = (u.pm - __builtin_amdgcn_readfirstlane(tstart[e])) * 256, ce = __builtin_amdgcn_readfirstlane(cnt[e]);
#pragma unroll
            for (int i2 = 0; i2 < 2; ++i2) { int R, C; pg8::stage_rc(tid * 16 + i2 * 8192, R, C);
#pragma unroll
                for (int h = 0; h < 2; ++h) { const int rr = rowbase + R + 128 * h; const unsigned tok = (rr < ce) ? list[(size_t)e * 16384 + rr] : 0u; v[h][i2] = tok * (unsigned)(lda * 2) + (unsigned)C * 2u; } }
        } else {
#pragma unroll
            for (int h = 0; h < 2; ++h)
#pragma unroll
                for (int i2 = 0; i2 < 2; ++i2) v[h][i2] = va[h][i2];
        }
    }
};
__device__ __forceinline__ void moe_tables(const Frame& F, const unsigned* gcnt) {
    LAS int* tstart = (LAS int*)(F.lds + P6S_OFF); LAS int* cnt = tstart + 64;
    if (F.tid == 0) { int run = 0; for (int e = 0; e < 32; ++e) { const int c = (int)__hip_atomic_load(gcnt + e, RLX_AGENT); cnt[e] = c; tstart[e] = run; run += (c + 255) >> 8; } tstart[32] = run; }
    __syncthreads();
}

__device__ __forceinline__ unsigned sortable(float f) { const unsigned u = __float_as_uint(f + 0.0f); return (u & 0x80000000u) ? ~u : (u | 0x80000000u); }
__device__ __forceinline__ void indexer_task(const Frame& F, int rowb, int t0) {
    const int lane = F.lane, c = lane & 31, hi = lane >> 5;
    const bf16_t* IQ = (const bf16_t*)(F.ws + WS_IQ); const bf16_t* IK = (const bf16_t*)(F.ws + WS_IK); const float* IW = (const float*)(F.ws + WS_IW);
    unsigned* MASK = (unsigned*)(F.ws + WS_MASK);
    LAS unsigned* KL = (LAS unsigned*)(F.lds + F.wave * 16384) + lane;
    const int ntile = ((t0 + 3) >> 5) + 1, ngrp = (ntile + 1) >> 1;
    for (int pass = 0; pass < 2; ++pass) {
        bf16x8 qa[4];
        { const int a = c >> 3, hb = (c >> 2) & 1, i = c & 3; const int tk = 2 * hb + ((a >> 1) ^ pass), hd = 4 * (a & 1) + i;
          const bf16_t* qp = IQ + (size_t)(rowb + t0 + tk) * 512 + hd * 64 + 8 * hi;
#pragma unroll
          for (int ks = 0; ks < 4; ++ks) qa[ks] = *(const bf16x8*)(qp + 16 * ks); }
        const int tA = t0 + 2 * hi + pass;
        float w8[8];
        { const f32x4* wp = (const f32x4*)(IW + (size_t)(rowb + tA) * 8); const f32x4 a0 = wp[0], a1 = wp[1];
#pragma unroll
          for (int j = 0; j < 4; ++j) { w8[j] = a0[j]; w8[4 + j] = a1[j]; } }
        const bf16_t* kpb = IK + (size_t)(rowb + c) * 64 + 8 * hi;
        for (int g = 0; g < ngrp; ++g) {
            bf16x8 kb[2][4];
#pragma unroll
            for (int tt = 0; tt < 2; ++tt) { const bf16_t* kp = kpb + (size_t)(2 * g + tt) * 2048;
#pragma unroll
                for (int ks = 0; ks < 4; ++ks) kb[tt][ks] = *(const bf16x8*)(kp + 16 * ks); }
#pragma unroll
            for (int tt = 0; tt < 2; ++tt) {
                f32x16 acc = {};
#pragma unroll
                for (int ks = 0; ks < 4; ++ks) acc = __builtin_amdgcn_mfma_f32_32x32x16_bf16(qa[ks], kb[tt][ks], acc, 0, 0, 0);
                float s0 = 0.f;
#pragma unroll
                for (int j = 0; j < 8; ++j) s0 += w8[j] * fmaxf(acc[j], 0.f);
                const int key = 32 * (2 * g + tt) + c;
                KL[(2 * g + tt) * 64] = (key <= tA) ? sortable(s0) : 0u;
            }
        }
        LDS_WAIT(); asm volatile("" ::: "memory");
        unsigned k0[64];
#pragma unroll
        for (int tl = 0; tl < 64; ++tl) { const unsigned v = KL[tl * 64]; k0[tl] = (tl < 2 * ngrp) ? v : 0u; }
        LDS_WAIT(); asm volatile("" ::: "memory");
        unsigned wlo = 0u, whi = 0u;
        if (t0 < 256) {
#pragma unroll
            for (int tl = 0; tl < 64; ++tl) {
                const unsigned long long b0 = __ballot(k0[tl] != 0u);
                const unsigned wv = hi ? (unsigned)(b0 >> 32) : (unsigned)b0;
                if (tl < 32) wlo = (c == tl) ? wv : wlo; else whi = (c == tl - 32) ? wv : whi;
            }
        } else {
            unsigned P0 = 0u;
            for (int bit = 31; bit >= 0; --bit) {
                const unsigned c0 = P0 | (1u << bit); int n0 = 0;
#pragma unroll
                for (int tl = 0; tl < 64; ++tl) n0 += (k0[tl] >= c0) ? 1 : 0;
#pragma unroll
                for (int o = 1; o < 32; o <<= 1) n0 += __shfl_xor(n0, o);
                if (n0 >= 256) P0 = c0;
            }
            int g0 = 0;
#pragma unroll
            for (int tl = 0; tl < 64; ++tl) g0 += (k0[tl] > P0) ? 1 : 0;
#pragma unroll
            for (int o = 1; o < 32; o <<= 1) g0 += __shfl_xor(g0, o);
            const int need0 = 256 - g0; int run0 = 0;
            const unsigned below = (1u << c) - 1u;
#pragma unroll
            for (int tl = 0; tl < 64; ++tl) {
                const bool e0 = k0[tl] == P0;
                const unsigned long long be0 = __ballot(e0);
                const unsigned m0 = hi ? (unsigned)(be0 >> 32) : (unsigned)be0;
                const bool s0 = (k0[tl] > P0) || (e0 && (run0 + __popc(m0 & below) < need0));
                run0 += __popc(m0);
                const unsigned long long b0 = __ballot(s0);
                const unsigned wv = hi ? (unsigned)(b0 >> 32) : (unsigned)b0;
                if (tl < 32) wlo = (c == tl) ? wv : wlo; else whi = (c == tl - 32) ? wv : whi;
            }
        }
        unsigned* mrow0 = MASK + (size_t)(rowb + tA) * 64;
        mrow0[c] = wlo; mrow0[32 + c] = whi;
    }
}
__device__ __forceinline__ void indexer_phase(const Frame& F) {
    const int gw = F.vcu * NWAVES + F.wave;
    const int b = gw >> 8, j = gw & 255;
    if (b < BATCH) {
        indexer_task(F, b * SEQ, 4 * j);
        indexer_task(F, b * SEQ, 4 * (511 - j));
    }
}

__device__ __forceinline__ s16x4 tr_read(const LAS unsigned char* p) {
    typedef short v4i16_t __attribute__((ext_vector_type(4)));
    return __builtin_bit_cast(s16x4, __builtin_amdgcn_ds_read_tr16_b64_v4i16((LAS v4i16_t*)p));
}
__device__ __forceinline__ int crow(int r, int hi) { return (r & 3) + 8 * (r >> 2) + 4 * hi; }
constexpr int RET_KP = 528, RET_VP = 144, RET_RP = 528;
constexpr int RET_KC = 0, RET_VC = 128 * RET_KP, RET_RT = RET_VC + 128 * RET_VP;
static_assert(RET_RT + 64 * RET_RP <= RING_BYTES, "retention LDS");
__device__ __forceinline__ void retention_phase(const Frame& F) {
    if (F.vcu >= 256) return;
    const int tid = F.tid, lane = F.lane, w = F.wave, r32 = lane & 31, hi = lane >> 5;
    const int bh = F.vcu >> 3, sl = F.vcu & 7, b = bh >> 2, h = bh & 3, e0 = 64 * sl, rowb = b * SEQ;
    const int Ti = w >> 1, eh = w & 1;
    const bf16_t* RQK = (const bf16_t*)(F.ws + WS_RQK); const bf16_t* RV = (const bf16_t*)(F.ws + WS_RV);
    bf16_t* Y = (bf16_t*)(F.ws + WS_Y); f32x2* ST = (f32x2*)(F.ws + WS_STATS);
    LAS unsigned char* KC = F.lds + RET_KC; LAS unsigned char* VC = F.lds + RET_VC; LAS unsigned char* RT = F.lds + RET_RT;
    const float lg = __log2f(1.0f - exp2f(-5.0f - (float)h));
    const float gam128 = exp2f(128.f * lg), cinv = exp2f(-128.f * lg);
    const int n0 = 16 * ((lane >> 4) & 1), q4 = (lane & 15) >> 2, p4 = lane & 3;
    for (int i = tid; i < 64 * RET_RP / 4; i += NTHREADS) ((LAS unsigned*)RT)[i] = 0u;
    f32x16 accR[2]; accR[0] = f32x16{}; accR[1] = f32x16{};
    for (int n = 0; n < 16; ++n) {
        const int T0 = rowb + 128 * n;
#pragma unroll
        for (int i = 0; i < 8; ++i) { const int qd = tid + NTHREADS * i, row = qd >> 5, ch = qd & 31;
            const u32x4 v = *(const u32x4*)(RQK + (size_t)(T0 + row) * 2048 + 1024 + h * 256 + ch * 8);
            *(LAS u32x4*)(KC + row * RET_KP + ch * 16) = v; }
#pragma unroll
        for (int i = 0; i < 2; ++i) { const int qd = tid + NTHREADS * i, row = qd >> 3, ch = qd & 7;
            const u32x4 v = *(const u32x4*)(RV + (size_t)(T0 + row) * 2048 + h * 512 + e0 + ch * 8);
            const float z = exp2f((float)(127 - row) * lg); u32x4 o;
            o.x = cvtpk(bf2f(v.x & 0xffffu) * z, bf2f(v.x >> 16) * z); o.y = cvtpk(bf2f(v.y & 0xffffu) * z, bf2f(v.y >> 16) * z);
            o.z = cvtpk(bf2f(v.z & 0xffffu) * z, bf2f(v.z >> 16) * z); o.w = cvtpk(bf2f(v.w & 0xffffu) * z, bf2f(v.w >> 16) * z);
            *(LAS u32x4*)(VC + row * RET_VP + ch * 16) = o; }
        bf16x8 qf[16];
        { const bf16_t* qp = RQK + (size_t)(T0 + 32 * Ti + r32) * 2048 + h * 256 + 8 * hi;
#pragma unroll
          for (int ks = 0; ks < 16; ++ks) qf[ks] = *(const bf16x8*)(qp + 16 * ks); }
        __syncthreads();
        f32x16 accY = f32x16{};
#pragma unroll
        for (int ks = 0; ks < 16; ++ks) { const bf16x8 bfr = *(const LAS bf16x8*)(RT + (32 * eh + r32) * RET_RP + (16 * ks + 8 * hi) * 2);
            accY = __builtin_amdgcn_mfma_f32_32x32x16_bf16(qf[ks], bfr, accY, 0, 0, 0); }
#pragma unroll
        for (int sj = 0; sj < 4; ++sj) {
            if (sj <= Ti) {
                f32x16 X = f32x16{};
#pragma unroll
                for (int ks = 0; ks < 16; ++ks) { const bf16x8 afr = *(const LAS bf16x8*)(KC + (32 * sj + r32) * RET_KP + (16 * ks + 8 * hi) * 2);
                    X = __builtin_amdgcn_mfma_f32_32x32x16_bf16(afr, qf[ks], X, 0, 0, 0); }
                const bool diag = (sj == Ti);
#pragma unroll
                for (int r = 0; r < 16; ++r) { float v = X[r] * cinv; if (diag && crow(r, hi) > r32) v = 0.f; X[r] = v; }
#pragma unroll
                for (int sp = 0; sp < 2; ++sp) {
                    u32x4 pw; pw.x = cvtpk(X[8 * sp + 0], X[8 * sp + 1]); pw.y = cvtpk(X[8 * sp + 2], X[8 * sp + 3]); pw.z = cvtpk(X[8 * sp + 4], X[8 * sp + 5]); pw.w = cvtpk(X[8 * sp + 6], X[8 * sp + 7]);
                    const int kr = 32 * sj + 16 * sp + 4 * hi;
                    const LAS unsigned char* vp = VC + (kr + q4) * RET_VP + (32 * eh + n0 + 4 * p4) * 2;
                    const s16x4 lo = tr_read(vp), hh = tr_read(vp + 8 * RET_VP);
                    const bf16x8 vb = {lo[0], lo[1], lo[2], lo[3], hh[0], hh[1], hh[2], hh[3]};
                    accY = __builtin_amdgcn_mfma_f32_32x32x16_bf16(__builtin_bit_cast(bf16x8, pw), vb, accY, 0, 0, 0);
                }
            }
        }
        {
            const int colg = h * 512 + e0 + 32 * eh + r32;
#pragma unroll
            for (int r = 0; r < 16; ++r) {
                const int trow = 32 * Ti + crow(r, hi);
                const float yv = accY[r] * exp2f((float)(trow + 1) * lg);
                Y[(size_t)(T0 + trow) * 2048 + colg] = (bf16_t)(cvtpk(yv, 0.f) & 0xffffu);
                const float s1 = half_sum(yv), s2 = half_sum(yv * yv);
                if (r32 == 0) ST[((size_t)(T0 + trow) * 4 + h) * 16 + 2 * sl + eh] = (f32x2){s1, s2};
            }
        }
#pragma unroll
        for (int et = 0; et < 2; ++et)
#pragma unroll
            for (int r = 0; r < 16; ++r) accR[et][r] *= gam128;
#pragma unroll
        for (int ks = 0; ks < 8; ++ks) {
            const int s0 = 16 * ks + 8 * hi;
            const LAS unsigned char* kp = KC + (s0 + q4) * RET_KP + (32 * w + n0 + 4 * p4) * 2;
            const s16x4 al = tr_read(kp), ah = tr_read(kp + 4 * RET_KP);
            const bf16x8 afr = {al[0], al[1], al[2], al[3], ah[0], ah[1], ah[2], ah[3]};
#pragma unroll
            for (int et = 0; et < 2; ++et) {
                const LAS unsigned char* vp = VC + (s0 + q4) * RET_VP + (32 * et + n0 + 4 * p4) * 2;
                const s16x4 bl = tr_read(vp), bhh = tr_read(vp + 4 * RET_VP);
                const bf16x8 bfr = {bl[0], bl[1], bl[2], bl[3], bhh[0], bhh[1], bhh[2], bhh[3]};
                accR[et] = __builtin_amdgcn_mfma_f32_32x32x16_bf16(afr, bfr, accR[et], 0, 0, 0);
            }
        }
        __syncthreads();
#pragma unroll
        for (int et = 0; et < 2; ++et)
#pragma unroll
            for (int g = 0; g < 4; ++g) { u32x2 o; o.x = cvtpk(accR[et][4 * g], accR[et][4 * g + 1]); o.y = cvtpk(accR[et][4 * g + 2], accR[et][4 * g + 3]);
                *(LAS u32x2*)(RT + (32 * et + r32) * RET_RP + (32 * w + 8 * g + 4 * hi) * 2) = o; }
    }
    __syncthreads();
}

namespace att {
constexpr int D = 128, QBLK = 32, KVBLK = 64, LDK = 256, LDQ = 1024;
constexpr float SCALE = 0.088388347648318440f, THR = 8.f;
constexpr size_t SHM_V = KVBLK * D * 2, SHM_K = KVBLK * D * 2;
#define KSWZ(row, colB) ((row) * 256 + ((colB) ^ (((row) & 7) << 4)))
#define SBAR() __builtin_amdgcn_sched_barrier(0)
__device__ __forceinline__ unsigned cvtpk_a(float lo, float hi) { unsigned r; asm volatile("v_cvt_pk_bf16_f32 %0, %1, %2" : "=v"(r) : "v"(lo), "v"(hi)); return r; }
__device__ __forceinline__ void maskp(f32x16& p0, f32x16& p1, u32x2 mw, int hi) {
    const unsigned a = mw.x >> (4 * hi), b = mw.y >> (4 * hi);
#pragma unroll
    for (int r = 0; r < 16; ++r) { const unsigned bit = 1u << ((r & 3) + 8 * (r >> 2)); p0[r] = (a & bit) ? p0[r] : -INFINITY; p1[r] = (b & bit) ? p1[r] : -INFINITY; }
}
__device__ __forceinline__ void partialSM(f32x16& p0, f32x16& p1, float& m_reg, float& mn, float& alpha) {
    constexpr float C = SCALE * 1.4426950408889634f;
    float pmax = p0[0];
#pragma unroll
    for (int r = 1; r < 16; ++r) pmax = fmaxf(pmax, p0[r]);
#pragma unroll
    for (int r = 0; r < 16; ++r) pmax = fmaxf(pmax, p1[r]);
    { auto rr = __builtin_amdgcn_permlane32_swap(__float_as_uint(pmax), __float_as_uint(pmax), false, false);
      pmax = fmaxf(__uint_as_float(rr[0]), __uint_as_float(rr[1])); }
    if (__builtin_expect(__all(pmax - m_reg <= THR / SCALE), 1)) { mn = m_reg; alpha = 1.f; }
    else { mn = fmaxf(m_reg, pmax); alpha = __builtin_amdgcn_exp2f((m_reg - mn) * C); m_reg = mn; }
    float mnC = -mn * C;
#pragma unroll
    for (int r = 0; r < 16; ++r) p0[r] = fmaf(p0[r], C, mnC);
#pragma unroll
    for (int r = 0; r < 16; ++r) p1[r] = fmaf(p1[r], C, mnC);
#pragma unroll
    for (int r = 0; r < 16; ++r) p0[r] = __builtin_amdgcn_exp2f(p0[r]);
}
__device__ __forceinline__ void finishSM(f32x16& p0, f32x16& p1, float alpha, float& l_reg, bf16x8& pa0, bf16x8& pa1, bf16x8& pa2, bf16x8& pa3) {
#pragma unroll
    for (int r = 0; r < 16; ++r) p1[r] = __builtin_amdgcn_exp2f(p1[r]);
    float ps = 0;
#pragma unroll
    for (int r = 0; r < 16; ++r) ps += p0[r];
#pragma unroll
    for (int r = 0; r < 16; ++r) ps += p1[r];
    { auto rr = __builtin_amdgcn_permlane32_swap(__float_as_uint(ps), __float_as_uint(ps), false, false);
      ps = __uint_as_float(rr[0]) + __uint_as_float(rr[1]); }
    l_reg = l_reg * alpha + ps;
#define PK4(P, BASE, OUT) do { unsigned a0 = cvtpk_a(P[BASE + 0], P[BASE + 1]), a1 = cvtpk_a(P[BASE + 2], P[BASE + 3]);   \
    unsigned b0 = cvtpk_a(P[BASE + 4], P[BASE + 5]), b1 = cvtpk_a(P[BASE + 6], P[BASE + 7]);                              \
    auto r0 = __builtin_amdgcn_permlane32_swap(a0, b0, false, false); auto r1 = __builtin_amdgcn_permlane32_swap(a1, b1, false, false); \
    u32x4 w = {r0[0], r1[0], r0[1], r1[1]}; OUT = __builtin_bit_cast(bf16x8, w); } while (0)
    PK4(p0, 0, pa0); PK4(p0, 8, pa1); PK4(p1, 0, pa2); PK4(p1, 8, pa3);
#undef PK4
}
__device__ __forceinline__ void qkt(f32x16& p0, f32x16& p1, const char* Ks, const char* Qs, const int* qa4, int r32, int hi, u32x2 mw) {
    { const unsigned a = mw.x >> (4 * hi), b = mw.y >> (4 * hi);
#pragma unroll
      for (int r = 0; r < 16; ++r) { const unsigned bit = 1u << ((r & 3) + 8 * (r >> 2)); p0[r] = (a & bit) ? 0.f : -INFINITY; p1[r] = (b & bit) ? 0.f : -INFINITY; } }
#pragma unroll
    for (int d0 = 0; d0 < 8; ++d0) { int cb = (d0 * 16 + hi * 8) * 2;
        bf16x8 b0 = *reinterpret_cast<const bf16x8*>(Ks + KSWZ(r32, cb));
        bf16x8 b1 = *reinterpret_cast<const bf16x8*>(Ks + KSWZ(32 + r32, cb));
        const bf16x8 q = *reinterpret_cast<const bf16x8*>(Qs + qa4[d0 & 3] + (d0 >> 2) * 128);
        p0 = __builtin_amdgcn_mfma_f32_32x32x16_bf16(b0, q, p0, 0, 0, 0);
        p1 = __builtin_amdgcn_mfma_f32_32x32x16_bf16(b1, q, p1, 0, 0, 0); }
}
__device__ __forceinline__ int v_st(int k, int c) { const int kk = (k & ~0xC) | ((k & 4) << 1) | ((k & 8) >> 1); return ((kk >> 3) * 4 + (c >> 5)) * 512 + ((kk & 7) * 32 + (c & 31)) * 2; }
__device__ __forceinline__ int v_rd_base(int lane) { return ((lane & 3) << 3) | (((lane >> 2) & 3) << 6) | (((lane >> 4) & 1) << 5) | (((lane >> 5) & 1) << 8); }
constexpr int v_rd_off(int d0, int ks, int half) { return d0 * 512 + ks * 4096 + half * 2048; }
template <int OFF> __device__ __forceinline__ s16x4 tr_read_i(int vb) {
    s16x4 r; asm volatile("ds_read_b64_tr_b16 %0, %1 offset:%2" : "=&v"(r) : "v"(vb), "i"(OFF) : "memory"); return r;
}
template <int D0> __device__ __forceinline__ void pv_one(f32x16& od, int vb, bf16x8 pa0, bf16x8 pa1, bf16x8 pa2, bf16x8 pa3) {
    const s16x4 l0 = tr_read_i<v_rd_off(D0, 0, 0)>(vb), h0 = tr_read_i<v_rd_off(D0, 0, 1)>(vb), l1 = tr_read_i<v_rd_off(D0, 1, 0)>(vb), h1 = tr_read_i<v_rd_off(D0, 1, 1)>(vb);
    const s16x4 l2 = tr_read_i<v_rd_off(D0, 2, 0)>(vb), h2 = tr_read_i<v_rd_off(D0, 2, 1)>(vb), l3 = tr_read_i<v_rd_off(D0, 3, 0)>(vb), h3 = tr_read_i<v_rd_off(D0, 3, 1)>(vb);
    asm volatile("s_waitcnt lgkmcnt(0)" ::: "memory"); SBAR();
#define PK(L, H) (bf16x8){L[0], L[1], L[2], L[3], H[0], H[1], H[2], H[3]}
    od = __builtin_amdgcn_mfma_f32_32x32x16_bf16(pa0, PK(l0, h0), od, 0, 0, 0);
    od = __builtin_amdgcn_mfma_f32_32x32x16_bf16(pa1, PK(l1, h1), od, 0, 0, 0);
    od = __builtin_amdgcn_mfma_f32_32x32x16_bf16(pa2, PK(l2, h2), od, 0, 0, 0);
    od = __builtin_amdgcn_mfma_f32_32x32x16_bf16(pa3, PK(l3, h3), od, 0, 0, 0);
#undef PK
}
__device__ __forceinline__ void pv_d0(f32x16* o, int vb, bf16x8 pa0, bf16x8 pa1, bf16x8 pa2, bf16x8 pa3) {
    pv_one<0>(o[0], vb, pa0, pa1, pa2, pa3); pv_one<1>(o[1], vb, pa0, pa1, pa2, pa3); pv_one<2>(o[2], vb, pa0, pa1, pa2, pa3); pv_one<3>(o[3], vb, pa0, pa1, pa2, pa3);
}
__device__ __forceinline__ void unit(const bf16_t* Qb, const bf16_t* __restrict__ Kh, const bf16_t* __restrict__ Vh, const unsigned* __restrict__ Mb, bf16_t* Ob, int seq, char* lds, const int tid) {
    const int wid = tid >> 6, lane = tid & 63, r32 = lane & 31, hi = lane >> 5;
    char* V_lds = lds; char* K_lds = lds + 2 * SHM_V;
    float* ws = (float*)(lds + 2 * SHM_V + 2 * SHM_K) + wid * 64; float* li_l = ws; float* al_l = ws + 32;
    float m_reg = -1e30f, l_reg = 0; f32x16 o[4] = {};
    const int widu = __builtin_amdgcn_readfirstlane(wid);
    char* Qs = lds + 69632 + widu * 8192; int qa4[4];
    { const int qsw = (r32 & 7) << 4;
#pragma unroll
      for (int i = 0; i < 4; ++i) qa4[i] = r32 * 256 + ((i * 32 + hi * 16) ^ qsw);
      const char* Qw = (const char*)(Qb + widu * D); const unsigned qo = (unsigned)(r32 * LDQ + hi * 8) * 2u;
#pragma unroll
      for (int d0 = 0; d0 < 8; ++d0) *(bf16x8*)(Qs + qa4[d0 & 3] + (d0 >> 2) * 128) = *(const bf16x8*)(Qw + (qo + (unsigned)(d0 * 32))); }
    const unsigned mo = (unsigned)r32 * 256u;
#define MLOAD(j) (*(const u32x2*)((const char*)Mb + (size_t)(j) * 8 + mo))
    const int sr = tid >> 4, sc = (tid & 15) * 8, vst0 = v_st(sr, sc), vst1 = v_st(32 + sr, sc);
    const int vb0 = (int)(uintptr_t)V_lds + v_rd_base(lane);
    struct { bf16x8 vs0, vs1, ks0, ks1; } sr_[1];
    const unsigned svo = (unsigned)(sr * LDK + sc) * 2u;
#define SLOAD(i, k0) do { const char* kt_ = (const char*)Kh + (size_t)(k0) * (LDK * 2); \
    sr_[i].vs0 = *(const bf16x8*)(kt_ + 256 + svo); sr_[i].vs1 = *(const bf16x8*)(kt_ + (32 * LDK * 2 + 256) + svo); \
    sr_[i].ks0 = *(const bf16x8*)(kt_ + svo); sr_[i].ks1 = *(const bf16x8*)(kt_ + 32 * LDK * 2 + svo); } while (0)
#define SWRITE(b, i) do { *(bf16x8*)(V_lds + (b) * SHM_V + vst0) = sr_[i].vs0;          \
    *(bf16x8*)(V_lds + (b) * SHM_V + vst1) = sr_[i].vs1; int kc = sc * 2;               \
    *(bf16x8*)(K_lds + (b) * SHM_K + KSWZ(sr, kc)) = sr_[i].ks0;                       \
    *(bf16x8*)(K_lds + (b) * SHM_K + KSWZ(32 + sr, kc)) = sr_[i].ks1; } while (0)
#define RESC(a) do { if (__any((a) < 1.f)) { if (hi == 0) al_l[r32] = (a); asm volatile("s_waitcnt lgkmcnt(0)" ::: "memory"); \
    _Pragma("unroll") for (int d = 0; d < 4; ++d) _Pragma("unroll") for (int r = 0; r < 16; ++r) o[d][r] *= al_l[crow(r, hi)]; } } while (0)
    f32x16 pA0, pA1, pB0, pB1; float mnA, mnB, alA, alB; bf16x8 pa0, pa1, pa2, pa3; const int NT = seq / KVBLK;
    u32x2 mwA, mwB;
    constexpr int SE = 0, SO = 0;
    mwA = MLOAD(0);
    SLOAD(SE, 0); asm volatile("s_waitcnt vmcnt(0)" ::: "memory"); SWRITE(0, SE); __syncthreads();
    qkt(pA0, pA1, K_lds, Qs, qa4, r32, hi, mwA); partialSM(pA0, pA1, m_reg, mnA, alA);
    SLOAD(SO, KVBLK);
    asm volatile("s_waitcnt vmcnt(0)" ::: "memory"); SWRITE(1, SO); __syncthreads();
    for (int j = 1; j + 1 < NT; j += 2) {
        mwB = MLOAD(j);
        SBAR(); qkt(pB0, pB1, K_lds + SHM_K, Qs, qa4, r32, hi, mwB);
        finishSM(pA0, pA1, alA, l_reg, pa0, pa1, pa2, pa3); SBAR();
        SLOAD(SO, (j + 1) * KVBLK); SBAR();
        pv_d0(o, vb0, pa0, pa1, pa2, pa3); partialSM(pB0, pB1, m_reg, mnB, alB);
        __syncthreads(); SWRITE(0, SE);
        RESC(alB); __syncthreads();
        mwA = MLOAD(j + 1);
        SBAR(); qkt(pA0, pA1, K_lds, Qs, qa4, r32, hi, mwA);
        finishSM(pB0, pB1, alB, l_reg, pa0, pa1, pa2, pa3); SBAR();
        SLOAD(SE, (j + 2) * KVBLK); SBAR();
        pv_d0(o, vb0 + (int)SHM_V, pa0, pa1, pa2, pa3); partialSM(pA0, pA1, m_reg, mnA, alA);
        __syncthreads(); SWRITE(1, SO);
        RESC(alA); __syncthreads();
    }
    mwB = MLOAD(NT - 1);
    SBAR(); qkt(pB0, pB1, K_lds + SHM_K, Qs, qa4, r32, hi, mwB);
    finishSM(pA0, pA1, alA, l_reg, pa0, pa1, pa2, pa3); SBAR();
    pv_d0(o, vb0, pa0, pa1, pa2, pa3); partialSM(pB0, pB1, m_reg, mnB, alB);
    __syncthreads(); RESC(alB);
    finishSM(pB0, pB1, alB, l_reg, pa0, pa1, pa2, pa3); SBAR();
    pv_d0(o, vb0 + (int)SHM_V, pa0, pa1, pa2, pa3);
    if (hi == 0) li_l[r32] = l_reg; asm volatile("s_waitcnt lgkmcnt(0)" ::: "memory");
    float rli[16];
#pragma unroll
    for (int r = 0; r < 16; ++r) rli[r] = __builtin_amdgcn_rcpf(li_l[crow(r, hi)]);
    char* Ow = (char*)(Ob + __builtin_amdgcn_readfirstlane(wid) * D);
    unsigned ob = (unsigned)(4 * hi * LDQ + r32) * 2u; asm volatile("" : "+v"(ob));
#pragma unroll
    for (int r = 0; r < 16; ++r) {
#pragma unroll
        for (int d0 = 0; d0 < 4; ++d0) *(bf16_t*)(Ow + (ob + (unsigned)((((r & 3) + 8 * (r >> 2)) * LDQ + d0 * 32) * 2))) = (bf16_t)(cvtpk(o[d0][r] * rli[r], 0.f) & 0xffffu); }
    __syncthreads();
#undef SLOAD
#undef SWRITE
#undef RESC
#undef MLOAD
}
#undef KSWZ
#undef SBAR
}
__device__ __forceinline__ void attention_phase(const Frame& F) {
    if (F.vcu >= 256) return;
    const int b = F.vcu >> 5, j = F.vcu & 31;
    bf16_t* AQ = (bf16_t*)(F.ws + WS_AQ); const bf16_t* AKV = (const bf16_t*)(F.ws + WS_AKV); const unsigned* MASK = (const unsigned*)(F.ws + WS_MASK);
    for (int rep = 0; rep < 2; ++rep) {
        const int qb = rep ? j : 63 - j; const int t0 = 32 * qb; const size_t row = (size_t)b * SEQ + t0;
        const int seq = ((t0 + 32 + 127) >> 7) << 7;
        att::unit(AQ + row * 1024, AKV + (size_t)b * SEQ * 256, AKV + (size_t)b * SEQ * 256 + 128, MASK + row * 64, AQ + row * 1024, seq, (char*)F.lds, F.tid);
    }
}

__device__ __forceinline__ void retnorm_phase(const Frame& F) {
    const int gw = F.vcu * NWAVES + F.wave, NGW = F.G * NWAVES, lane = F.lane;
    bf16_t* Y = (bf16_t*)(F.ws + WS_Y); const bf16_t* RG = (const bf16_t*)(F.ws + WS_RG); const f32x2* ST = (const f32x2*)(F.ws + WS_STATS);
    for (int t = gw; t < T; t += NGW) {
#pragma unroll
        for (int c = 0; c < 4; ++c) {
            f32x2 st = ST[((size_t)t * 4 + c) * 16 + (lane & 15)];
#pragma unroll
            for (int o = 1; o < 16; o <<= 1) { st.x += __shfl_xor(st.x, o); st.y += __shfl_xor(st.y, o); }
            const float mu = st.x * (1.f / 512.f); const float var = fmaxf(st.y * (1.f / 512.f) - mu * mu, 0.f); const float rs = 1.0f / sqrtf(var + GN_EPS);
            const size_t off = (size_t)t * 2048 + c * 512 + lane * 8;
            const u32x4 yv = *(const u32x4*)(Y + off), gv = *(const u32x4*)(RG + off); u32x4 ov;
#define RN(a, g) cvtpk((bf2f((a) & 0xffffu) - mu) * rs * bf2f((g) & 0xffffu), (bf2f((a) >> 16) - mu) * rs * bf2f((g) >> 16))
            ov.x = RN(yv.x, gv.x); ov.y = RN(yv.y, gv.y); ov.z = RN(yv.z, gv.z); ov.w = RN(yv.w, gv.w);
#undef RN
            *(u32x4*)(Y + off) = ov;
        }
    }
}

__device__ __forceinline__ void ln1_router_phase(const Frame& F, const Args& A, int layer) {
    const int tid = F.tid, lane = F.lane, w = F.wave;
    LAS float* Wl = (LAS float*)F.lds;
    LAS int* lcnt = (LAS int*)(F.lds + P6S_OFF);
    LAS int* lbase = lcnt + 32;
    LAS int* rexp = lbase + 32;
    LAS int* rpos = rexp + 128;
    LAS float* rwt = (LAS float*)(rpos + 128);
    const float* gw_ = A.grp_w + (size_t)layer * 1024 * 4; const float* ew_ = A.exp_w + (size_t)layer * 1024 * 32;
    for (int i = tid; i < 4096; i += NTHREADS) { const int k = i >> 2, c = i & 3; Wl[c * 1024 + k] = gw_[i]; }
    for (int i = tid; i < 32768; i += NTHREADS) { const int k = i >> 5, c = i & 31; Wl[(4 + c) * 1024 + k] = ew_[i]; }
    if (tid < 32) lcnt[tid] = 0;
    __syncthreads();
    const float* U = A.out; float* H = (float*)(F.ws + WS_H); bf16_t* HB = (bf16_t*)(F.ws + WS_XB);
    const float* g1 = A.ln1_g + layer * 1024; const float* b1 = A.ln1_b + layer * 1024;
    const float* gb = A.grp_b + layer * 4; const float* eb = A.exp_b + layer * 32;
    unsigned* gcnt = (unsigned*)(F.ws + WS_CTL) + CW_CNT + 64 * layer;
    unsigned* list = (unsigned*)(F.ws + WS_LIST); unsigned* tokslot = (unsigned*)(F.ws + WS_TOKSLOT); float* tokw = (float*)(F.ws + WS_TOKSLOT + 512 * 1024);
    const int rbase = F.vcu * 64;
    if (rbase < T) {
        for (int rr = 0; rr < 8; ++rr) {
            const int lr = w * 8 + rr, row = rbase + lr;
            f32x4 v[4]; float s = 0.f;
#pragma unroll
            for (int j = 0; j < 4; ++j) { v[j] = *(const f32x4*)(U + (size_t)row * 1024 + 256 * j + 4 * lane); s += (v[j].x + v[j].y) + (v[j].z + v[j].w); }
            const float mean = wave_sum(s) * (1.f / 1024.f); float s2 = 0.f;
#pragma unroll
            for (int j = 0; j < 4; ++j) { v[j] = v[j] - mean; s2 += (v[j].x * v[j].x + v[j].y * v[j].y) + (v[j].z * v[j].z + v[j].w * v[j].w); }
            const float rstd = 1.0f / sqrtf(wave_sum(s2) * (1.f / 1024.f) + LN_EPS);
#pragma unroll
            for (int j = 0; j < 4; ++j) { const f32x4 gg = *(const f32x4*)(g1 + 256 * j + 4 * lane), bb = *(const f32x4*)(b1 + 256 * j + 4 * lane);
                v[j] = v[j] * rstd * gg + bb;
                *(f32x4*)(H + (size_t)row * 1024 + 256 * j + 4 * lane) = v[j];
                u32x2 o; o.x = cvtpk(v[j].x, v[j].y); o.y = cvtpk(v[j].z, v[j].w); *(u32x2*)(HB + (size_t)row * 1024 + 256 * j + 4 * lane) = o; }
            float lg[36];
#pragma unroll
            for (int c = 0; c < 36; ++c) { float a = 0.f;
#pragma unroll
                for (int j = 0; j < 4; ++j) { const f32x4 wv = *(const LAS f32x4*)(Wl + c * 1024 + 256 * j + 4 * lane); a += (v[j].x * wv.x + v[j].y * wv.y) + (v[j].z * wv.z + v[j].w * wv.w); }
                lg[c] = wave_sum(a); }
            float gl[4];
#pragma unroll
            for (int i = 0; i < 4; ++i) gl[i] = lg[i] + gb[i];
            int gs = 0; float gm = gl[0];
#pragma unroll
            for (int i = 1; i < 4; ++i) if (gl[i] > gm) { gm = gl[i]; gs = i; }
            float den = 0.f;
#pragma unroll
            for (int i = 0; i < 4; ++i) den += __expf(gl[i] - gm);
            const float pg = 1.0f / den;
            float el[8];
#pragma unroll
            for (int i = 0; i < 8; ++i) { const float a0 = lg[4 + i] + eb[i], a1 = lg[12 + i] + eb[8 + i], a2 = lg[20 + i] + eb[16 + i], a3 = lg[28 + i] + eb[24 + i];
                el[i] = gs == 0 ? a0 : gs == 1 ? a1 : gs == 2 ? a2 : a3; }
            int i1 = 0; float m1 = el[0];
#pragma unroll
            for (int i = 1; i < 8; ++i) if (el[i] > m1) { m1 = el[i]; i1 = i; }
            int i2 = -1; float m2 = -INFINITY;
#pragma unroll
            for (int i = 0; i < 8; ++i) if (i != i1 && el[i] > m2) { m2 = el[i]; i2 = i; }
            const float e2 = __expf(m2 - m1); const float wt1 = pg / (1.f + e2), wt2 = pg * e2 / (1.f + e2);
            if (lane == 0) {
                const int x1 = gs * 8 + i1, x2 = gs * 8 + i2;
                rexp[lr * 2] = x1; rexp[lr * 2 + 1] = x2; rwt[lr * 2] = wt1; rwt[lr * 2 + 1] = wt2;
                rpos[lr * 2] = __hip_atomic_fetch_add(lcnt + x1, 1, __ATOMIC_RELAXED, __HIP_MEMORY_SCOPE_WORKGROUP);
                rpos[lr * 2 + 1] = __hip_atomic_fetch_add(lcnt + x2, 1, __ATOMIC_RELAXED, __HIP_MEMORY_SCOPE_WORKGROUP);
            }
        }
    }
    __syncthreads();
    if (tid < 32) { const int c = lcnt[tid]; lbase[tid] = c > 0 ? (int)__hip_atomic_fetch_add(gcnt + tid, (unsigned)c, RLX_AGENT) : 0; }
    __syncthreads();
    if (tid < 128 && rbase < T) { const int lr = tid >> 1, k = tid & 1, row = rbase + lr; const int e = rexp[tid]; const int pos = lbase[e] + rpos[tid];
        list[(size_t)e * 16384 + pos] = (unsigned)row; tokslot[row * 2 + k] = ((unsigned)e << 16) | (unsigned)pos; tokw[row * 2 + k] = rwt[tid]; }
    __syncthreads();
}

__device__ __forceinline__ void ln2_phase(const Frame& F, const Args& A, int layer) {
    const int gw = F.vcu * NWAVES + F.wave, NGW = F.G * NWAVES, lane = F.lane;
    const LAS int* tstart = (const LAS int*)(F.lds + P6S_OFF);
    const float* H = (const float*)(F.ws + WS_H); const bf16_t* Y2 = (const bf16_t*)(F.ws + WS_Y2);
    const unsigned* tokslot = (const unsigned*)(F.ws + WS_TOKSLOT); const float* tokw = (const float*)(F.ws + WS_TOKSLOT + 512 * 1024);
    const float* g2 = A.ln2_g + layer * 1024; const float* b2 = A.ln2_b + layer * 1024;
    bf16_t* XB = (bf16_t*)(F.ws + WS_XB);
    for (int row = gw; row < T; row += NGW) {
        const unsigned ts0 = tokslot[row * 2], ts1 = tokslot[row * 2 + 1]; const float w0 = tokw[row * 2], w1 = tokw[row * 2 + 1];
        const size_t s0 = (size_t)tstart[ts0 >> 16] * 256 + (ts0 & 0xffffu), s1 = (size_t)tstart[ts1 >> 16] * 256 + (ts1 & 0xffffu);
        f32x4 v[4]; float s = 0.f;
#pragma unroll
        for (int j = 0; j < 4; ++j) { const int col = 256 * j + 4 * lane;
            const f32x4 hv = *(const f32x4*)(H + (size_t)row * 1024 + col);
            const u32x2 ya = *(const u32x2*)(Y2 + s0 * 1024 + col), yb = *(const u32x2*)(Y2 + s1 * 1024 + col);
            f32x4 fa = {bf2f(ya.x & 0xffffu), bf2f(ya.x >> 16), bf2f(ya.y & 0xffffu), bf2f(ya.y >> 16)}, fb = {bf2f(yb.x & 0xffffu), bf2f(yb.x >> 16), bf2f(yb.y & 0xffffu), bf2f(yb.y >> 16)};
            v[j] = hv * ALPHA + fa * w0 + fb * w1; s += (v[j].x + v[j].y) + (v[j].z + v[j].w); }
        const float mean = wave_sum(s) * (1.f / 1024.f); float s2 = 0.f;
#pragma unroll
        for (int j = 0; j < 4; ++j) { v[j] = v[j] - mean; s2 += (v[j].x * v[j].x + v[j].y * v[j].y) + (v[j].z * v[j].z + v[j].w * v[j].w); }
        const float rstd = 1.0f / sqrtf(wave_sum(s2) * (1.f / 1024.f) + LN_EPS);
#pragma unroll
        for (int j = 0; j < 4; ++j) { const int col = 256 * j + 4 * lane; const f32x4 gg = *(const f32x4*)(g2 + col), bb = *(const f32x4*)(b2 + col);
            v[j] = v[j] * rstd * gg + bb; *(f32x4*)(A.out + (size_t)row * 1024 + col) = v[j];
            u32x2 o; o.x = cvtpk(v[j].x, v[j].y); o.y = cvtpk(v[j].z, v[j].w); *(u32x2*)(XB + (size_t)row * 1024 + col) = o; }
    }
}

__global__ void __launch_bounds__(NTHREADS, 2) fwd_megakernel(Args args) {
    extern __shared__ __attribute__((aligned(16))) unsigned char lds_raw[];
    Frame F;
    F.lds = (LAS unsigned char*)lds_raw; F.tid = threadIdx.x; F.lane = F.tid & 63; F.wave = __builtin_amdgcn_readfirstlane(F.tid >> 6);
    F.G = gridDim.x; { const int bx = blockIdx.x; F.vcu = (F.G % 8 == 0) ? (bx % 8) * (F.G / 8) + bx / 8 : bx; }
    F.ws = args.ws;
    volatile LAS unsigned* MISC = (volatile LAS unsigned*)(F.lds + MISC_OFF);
    for (int u = F.tid; u < 256; u += NTHREADS) MISC[u] = 0u;
    __syncthreads();
    unsigned* ctl = (unsigned*)(F.ws + WS_CTL);
    XcdBarrier bar = xcd_barrier_post(ctl + CW_BAR, MISC + 8);
#define GRID_BAR() do { size_t _zb = 0; asm volatile("" : "+s"(_zb)); bar.bar = (unsigned*)(args.ws + _zb + WS_CTL) + CW_BAR; xcd_barrier(bar); } while (0)
    unsigned char* ws = F.ws;
    Args A = args;
#define REFRESH() do { size_t _z = 0; int _l = layer; int _t = threadIdx.x; asm volatile("" : "+s"(_z), "+s"(_l), "+v"(_t)); \
        ws = args.ws + _z; F.ws = ws; A.ws = ws; A.out = args.out + _z; A.x = args.x + _z; L = _l; F.tid = _t; F.lane = _t & 63; F.wave = __builtin_amdgcn_readfirstlane(_t >> 6); } while (0)
    for (int layer = 0; layer < DEPTH; ++layer) {
        int L = layer;
        REFRESH();
        if (PH(0)) { p0_convert(F, A, L); }
        GRID_BAR();
        REFRESH();
        if (PH(1)) { pg8::DenseSched S; S.init((const bf16_t*)(ws + WS_XB), 1024, (const bf16_t*)(ws + WS_WIN), T, NV, 1024, F.G, (int)blockIdx.x, F.tid);
          EpiInProj E{ws};
          pg8::gemm_phase<EpiInProj, pg8::DenseSched, true, false>(F.lds, F.tid, 1024, S, E); }
        GRID_BAR();
        REFRESH();
        if (PH(2)) { indexer_phase(F); }
        __syncthreads();
        REFRESH();
        if (PH(3)) { retention_phase(F); }
        GRID_BAR();
        REFRESH();
        if (PH(4)) { attention_phase(F); }
        REFRESH();
        if (PH(5)) { retnorm_phase(F); }
        GRID_BAR();
        REFRESH();
        if (PH(6)) { pg8::DenseSched S; S.init((const bf16_t*)(ws + WS_Y), 2048, (const bf16_t*)(ws + WS_WR), T, 1024, 2048, F.G, (int)blockIdx.x, F.tid);
          EpiGate<0> E{(const bf16_t*)(ws + WS_GATES), 0, (float*)(ws + WS_TMP32), nullptr};
          pg8::gemm_phase<EpiGate<0>, pg8::DenseSched, false, false>(F.lds, F.tid, 2048, S, E); }
        REFRESH();
        if (PH(6)) { pg8::DenseSched S; S.init((const bf16_t*)(ws + WS_AQ), 1024, (const bf16_t*)(ws + WS_WD), T, 1024, 1024, F.G, (int)blockIdx.x, F.tid);
          EpiGate<1> E{(const bf16_t*)(ws + WS_GATES), 1024, (float*)(ws + WS_TMP32), (bf16_t*)(ws + WS_XB)};
          pg8::gemm_phase<EpiGate<1>, pg8::DenseSched, false, false>(F.lds, F.tid, 1024, S, E); }
        GRID_BAR();
        REFRESH();
        if (PH(7)) { pg8::DenseSched S; S.init((const bf16_t*)(ws + WS_XB), 1024, (const bf16_t*)(ws + WS_WO), T, 1024, 1024, F.G, (int)blockIdx.x, F.tid);
          EpiResid E{L == 0 ? A.x : (const float*)A.out, A.out};
          pg8::gemm_phase<EpiResid, pg8::DenseSched, false, false>(F.lds, F.tid, 1024, S, E); }
        GRID_BAR();
        REFRESH();
        if (PH(8)) { ln1_router_phase(F, A, L); }
        GRID_BAR();
        REFRESH();
        moe_tables(F, (unsigned*)(ws + WS_CTL) + CW_CNT + 64 * L);
        if (PH(9)) { MoeSched S; S.tstart = (const LAS int*)(F.lds + P6S_OFF); S.cnt = S.tstart + 64; S.A = (const bf16_t*)(ws + WS_XB); S.lda = 1024; S.Bt = (const bf16_t*)(ws + WS_WGU); S.bstride = (size_t)1024 * 1024; S.K = 1024;
          S.G = F.G; S.c = (int)blockIdx.x; S.gather = true; S.list = (const unsigned*)(ws + WS_LIST); S.tid = F.tid; pg8::plain_va(S.va, 1024, F.tid);
          EpiSwiGLU E{(bf16_t*)(ws + WS_ACT)};
          pg8::gemm_phase<EpiSwiGLU, MoeSched, true, true>(F.lds, F.tid, 1024, S, E); }
        GRID_BAR();
        REFRESH();
        if (PH(10)) { MoeSched S; S.tstart = (const LAS int*)(F.lds + P6S_OFF); S.cnt = S.tstart + 64; S.A = (const bf16_t*)(ws + WS_ACT); S.lda = 512; S.Bt = (const bf16_t*)(ws + WS_WDN); S.bstride = (size_t)1024 * 512; S.K = 512;
          S.G = F.G; S.c = (int)blockIdx.x; S.gather = false; S.list = nullptr; S.tid = F.tid; pg8::plain_va(S.va, 512, F.tid);
          EpiPlain E{(bf16_t*)(ws + WS_Y2), 1024};
          pg8::gemm_phase<EpiPlain, MoeSched, true, false>(F.lds, F.tid, 512, S, E); }
        GRID_BAR();
        REFRESH();
        if (PH(11)) { ln2_phase(F, A, L); }
        GRID_BAR();
    }
}

extern "C" void kernel_launch(void* const* d_in, const int* in_sizes, int n_in, void* d_out, int out_size, void* d_ws, size_t ws_size, hipStream_t stream) {
    static int grid = 0;
    if (grid == 0) {
        if (n_in != 16 || in_sizes[0] != T * D_MODEL || out_size != T * D_MODEL || ws_size < WS_END) {
            fprintf(stderr, "kernel_launch: unexpected shapes: n_in %d in0 %d out %d ws %zu (need %zu)\n", n_in, n_in > 0 ? in_sizes[0] : -1, out_size, ws_size, (size_t)WS_END); grid = -1; return; }
        int dev = 0, cus = 0, per_cu = 0;
        if (hipGetDevice(&dev) != hipSuccess || hipDeviceGetAttribute(&cus, hipDeviceAttributeMultiprocessorCount, dev) != hipSuccess) { grid = -1; return; }
        if (hipFuncSetAttribute((const void*)fwd_megakernel, hipFuncAttributeMaxDynamicSharedMemorySize, LDS_BYTES) != hipSuccess) { fprintf(stderr, "kernel_launch: hipFuncSetAttribute failed\n"); grid = -1; return; }
        if (hipOccupancyMaxActiveBlocksPerMultiprocessor(&per_cu, (const void*)fwd_megakernel, NTHREADS, LDS_BYTES) != hipSuccess || per_cu < 1) {
            fprintf(stderr, "kernel_launch: occupancy query reports %d blocks per CU\n", per_cu); }
        (void)hipGetLastError();
        grid = cus;
        if (grid != 256) fprintf(stderr, "kernel_launch: %d CUs (built for 256)\n", grid);
    }
    if (grid < 0) return;
    (void)hipMemsetAsync((char*)d_ws + WS_CTL, 0, CTL_BYTES, stream);
    Args a{};
    a.x = (const float*)d_in[0]; a.w_in = (const float*)d_in[1]; a.w_ret_o = (const float*)d_in[2]; a.w_dsa_o = (const float*)d_in[3]; a.w_out = (const float*)d_in[4];
    a.ln1_g = (const float*)d_in[5]; a.ln1_b = (const float*)d_in[6]; a.grp_w = (const float*)d_in[7]; a.grp_b = (const float*)d_in[8]; a.exp_w = (const float*)d_in[9]; a.exp_b = (const float*)d_in[10];
    a.w_gate = (const float*)d_in[11]; a.w_up = (const float*)d_in[12]; a.w_down = (const float*)d_in[13]; a.ln2_g = (const float*)d_in[14]; a.ln2_b = (const float*)d_in[15];
    a.out = (float*)d_out; a.ws = (unsigned char*)d_ws;
    void* kargs[] = {&a};
    hipError_t e = hipLaunchCooperativeKernel((const void*)fwd_megakernel, dim3(grid), dim3(NTHREADS), kargs, LDS_BYTES, stream);
    if (e != hipSuccess) fprintf(stderr, "kernel_launch: cooperative launch failed: %s (grid %d)\n", hipGetErrorString(e), grid);
}
```
